# Optimizing an MI355X kernel written in HIP

```python
import jax, jax.numpy as jnp
from jax import lax
import numpy as np

D_MODEL = 1024
BATCH = 8
SEQ = 4096
DEPTH = 1

GRID_W = 64
PLE_DIM = 256
D_FF = 2816
ATTN_HEADS = 8
HEAD_DIM = 64
D_ATTN = ATTN_HEADS * HEAD_DIM
NA_MAX_ROWS = 8
NA_COLS = 16
POOL_GROUPS = 4
POOL_GROUP_DIM = 128
D_POOL = POOL_GROUPS * POOL_GROUP_DIM
POOL_WINDOWS = (2, 4, 8, 16)
RPB_ROWS = 2 * NA_MAX_ROWS - 1
RPB_COLS = 2 * NA_COLS - 1
D_IN = 3 * D_ATTN + D_POOL + 2 * D_MODEL
RMS_EPS = 1e-6

kernel_name = "hybrid_natten_pool_macaron_encoder"


def rms_norm(x, g):
    xf = x.astype(jnp.float32)
    y = xf * lax.rsqrt(jnp.mean(xf * xf, axis=-1, keepdims=True) + RMS_EPS)
    return (y * g.astype(jnp.float32)).astype(x.dtype)


def swiglu(x, w_gate, w_up, w_down):
    return (jax.nn.silu(x @ w_gate) * (x @ w_up)) @ w_down


def neighbourhood_attention(q, k, v, rpb):
    B, S, _ = q.shape
    rows = S // GRID_W
    kr = min(NA_MAX_ROWS, rows)

    def to_grid(t):
        return t.reshape(B, rows, GRID_W, ATTN_HEADS, HEAD_DIM).transpose(0, 3, 1, 2, 4)

    qg = to_grid(q * (HEAD_DIM ** -0.5))
    kg, vg = to_grid(k), to_grid(v)

    cols = jnp.arange(GRID_W)
    col_start = jnp.clip(cols - NA_COLS // 2, 0, GRID_W - NA_COLS)
    col_idx = col_start[:, None] + jnp.arange(NA_COLS)[None, :]
    dc = col_idx - cols[:, None] + (NA_COLS - 1)

    def row_block(r):
        rs = jnp.clip(r - kr // 2, 0, rows - kr)
        k_rows = lax.dynamic_slice_in_dim(kg, rs, kr, axis=2)
        v_rows = lax.dynamic_slice_in_dim(vg, rs, kr, axis=2)
        kw = k_rows[:, :, :, col_idx, :]
        vw = v_rows[:, :, :, col_idx, :]
        q_row = lax.dynamic_index_in_dim(qg, r, axis=2, keepdims=False)
        s = jnp.einsum('bhcd,bhicjd->bhcij', q_row, kw).astype(jnp.float32)
        dr = rs + jnp.arange(kr) - r + (NA_MAX_ROWS - 1)
        bias = rpb[:, dr, :][:, :, dc]
        s = s + bias.transpose(0, 2, 1, 3)[None].astype(jnp.float32)
        pw = jax.nn.softmax(s.reshape(B, ATTN_HEADS, GRID_W, kr * NA_COLS), axis=-1)
        pw = pw.reshape(B, ATTN_HEADS, GRID_W, kr, NA_COLS).astype(v.dtype)
        return jnp.einsum('bhcij,bhicjd->bhcd', pw, vw)

    out = lax.map(row_block, jnp.arange(rows))
    return out.transpose(1, 0, 3, 2, 4).reshape(B, S, D_ATTN)


def multiscale_pool(xp, pool_w, pool_scale):
    B, S, _ = xp.shape
    xg = xp.reshape(B, S, POOL_GROUPS, POOL_GROUP_DIM)
    csum = jnp.cumsum(xg.astype(jnp.float32), axis=1)
    csum = jnp.concatenate([jnp.zeros_like(csum[:, :1]), csum], axis=1)
    half = jnp.array([w // 2 for w in POOL_WINDOWS], dtype=jnp.int32)
    t = jnp.arange(S, dtype=jnp.int32)[:, None]
    lo = jnp.clip(t - half[None, :], 0, S)
    hi = jnp.clip(t + half[None, :], 0, S)
    gidx = jnp.arange(POOL_GROUPS)[None, :]
    window_sum = csum[:, hi, gidx] - csum[:, lo, gidx]
    count = (hi - lo).astype(jnp.float32)[None, :, :, None]
    pooled = (window_sum / count - xg.astype(jnp.float32)).astype(xp.dtype)
    y = jnp.einsum('bsgc,gcd->bsgd', pooled, pool_w).reshape(B, S, D_POOL)
    return y * pool_scale


def hybrid_mixer(u, w_in, rpb, pool_w, pool_scale, w_br_attn, w_br_pool, w_out):
    proj = u @ w_in
    splits = [D_ATTN, 2 * D_ATTN, 3 * D_ATTN, 3 * D_ATTN + D_POOL, 3 * D_ATTN + D_POOL + D_MODEL]
    q, k, v, xp, g_attn, g_pool = jnp.split(proj, splits, axis=-1)
    y_attn = neighbourhood_attention(q, k, v, rpb) @ w_br_attn
    y_pool = multiscale_pool(xp, pool_w, pool_scale) @ w_br_pool
    merged = jax.nn.sigmoid(g_attn) * y_attn + jax.nn.sigmoid(g_pool) * y_pool
    return merged @ w_out


def setup_inputs(seed: int = 0) -> dict:
    key = jax.random.key(seed)
    ks = jax.random.split(key, 32)

    def nrm(k, shape, scale):
        return jax.random.normal(k, shape, jnp.float32) * scale

    def gain(k):
        return 1.0 + 0.05 * jax.random.normal(k, (DEPTH, D_MODEL), jnp.float32)

    return {
        "x": nrm(ks[0], (BATCH, SEQ, D_MODEL), 1.0),
        "p": nrm(ks[1], (DEPTH, BATCH, SEQ, PLE_DIM), 1.0),
        "ffn1_pre_g": gain(ks[2]),
        "ffn1_post_g": gain(ks[3]),
        "ffn1_w_gate": nrm(ks[4], (DEPTH, D_MODEL, D_FF), D_MODEL ** -0.5),
        "ffn1_w_up": nrm(ks[5], (DEPTH, D_MODEL, D_FF), D_MODEL ** -0.5),
        "ffn1_w_down": nrm(ks[6], (DEPTH, D_FF, D_MODEL), D_FF ** -0.5),
        "mix_pre_g": gain(ks[7]),
        "mix_post_g": gain(ks[8]),
        "w_in": nrm(ks[9], (DEPTH, D_MODEL, D_IN), D_MODEL ** -0.5),
        "rpb": nrm(ks[10], (DEPTH, ATTN_HEADS, RPB_ROWS, RPB_COLS), 0.5),
        "pool_w": nrm(ks[11], (DEPTH, POOL_GROUPS, POOL_GROUP_DIM, POOL_GROUP_DIM), POOL_GROUP_DIM ** -0.5),
        "pool_scale": 1.0 + 0.05 * jax.random.normal(ks[12], (DEPTH, D_POOL), jnp.float32),
        "w_br_attn": nrm(ks[13], (DEPTH, D_ATTN, D_MODEL), D_ATTN ** -0.5),
        "w_br_pool": nrm(ks[14], (DEPTH, D_POOL, D_MODEL), D_POOL ** -0.5),
        "w_out": nrm(ks[15], (DEPTH, D_MODEL, D_MODEL), D_MODEL ** -0.5),
        "ffn2_pre_g": gain(ks[16]),
        "ffn2_post_g": gain(ks[17]),
        "ffn2_w_gate": nrm(ks[18], (DEPTH, D_MODEL, D_FF), D_MODEL ** -0.5),
        "ffn2_w_up": nrm(ks[19], (DEPTH, D_MODEL, D_FF), D_MODEL ** -0.5),
        "ffn2_w_down": nrm(ks[20], (DEPTH, D_FF, D_MODEL), D_FF ** -0.5),
        "ple_pre_g": gain(ks[21]),
        "ple_post_g": gain(ks[22]),
        "ple_w_proj": nrm(ks[23], (DEPTH, PLE_DIM, D_MODEL), PLE_DIM ** -0.5),
        "ple_w_gate": nrm(ks[24], (DEPTH, D_MODEL, D_MODEL), D_MODEL ** -0.5),
    }


def reference(x, p, ffn1_pre_g, ffn1_post_g, ffn1_w_gate, ffn1_w_up, ffn1_w_down,
              mix_pre_g, mix_post_g, w_in, rpb, pool_w, pool_scale, w_br_attn, w_br_pool, w_out,
              ffn2_pre_g, ffn2_post_g, ffn2_w_gate, ffn2_w_up, ffn2_w_down,
              ple_pre_g, ple_post_g, ple_w_proj, ple_w_gate):
    h = x
    for i in range(DEPTH):
        f = swiglu(rms_norm(h, ffn1_pre_g[i]), ffn1_w_gate[i], ffn1_w_up[i], ffn1_w_down[i])
        h = h + 0.5 * rms_norm(f, ffn1_post_g[i])
        m = hybrid_mixer(rms_norm(h, mix_pre_g[i]), w_in[i], rpb[i], pool_w[i], pool_scale[i],
                         w_br_attn[i], w_br_pool[i], w_out[i])
        h = h + rms_norm(m, mix_post_g[i])
        f = swiglu(rms_norm(h, ffn2_pre_g[i]), ffn2_w_gate[i], ffn2_w_up[i], ffn2_w_down[i])
        h = h + 0.5 * rms_norm(f, ffn2_post_g[i])
        e = (p[i] @ ple_w_proj[i]) * jax.nn.sigmoid(rms_norm(h, ple_pre_g[i]) @ ple_w_gate[i])
        h = h + rms_norm(e, ple_post_g[i])
    return h
```

```cpp
#include <hip/hip_runtime.h>
#include <cstdint>
#include <cstdio>

#define LAS __attribute__((address_space(3)))
typedef unsigned short bf16;
typedef short bf16x8 __attribute__((ext_vector_type(8)));
typedef float f32x4 __attribute__((ext_vector_type(4)));
typedef unsigned u32x4 __attribute__((ext_vector_type(4)));
typedef unsigned u32x2 __attribute__((ext_vector_type(2)));

constexpr int BATCH = 8, SEQ = 4096, DM = 1024, M = BATCH * SEQ, DFF = 2816, NGU = 2 * DFF, DIN = 4096;
constexpr int DATT = 512, DPOOL = 512, PLE = 256, NH = 8, HD = 64;
constexpr float EPS = 1e-6f;
constexpr int NT = 512, NWAVES = 8;

constexpr size_t MiB = 1u << 20;
constexpr size_t WS_W1GU = 1 * MiB, WS_W1D = 12 * MiB, WS_WIN = 18 * MiB, WS_WBA = 26 * MiB, WS_WCOMB = 27 * MiB, WS_WOUT = 28 * MiB;
constexpr size_t WS_W2GU = 30 * MiB, WS_W2D = 41 * MiB, WS_WPG = 47 * MiB, WS_WPP = 49 * MiB;
constexpr size_t WS_U = 64 * MiB;
constexpr size_t WS_ATT = 64 * MiB, WS_POOLED = 96 * MiB;
constexpr size_t WS_R1 = 128 * MiB;
constexpr size_t WS_T2 = 256 * MiB;
constexpr size_t WS_R2 = 384 * MiB;
constexpr size_t WS_MERGED = 448 * MiB;

struct P {
    const float *x, *p, *g1pre, *g1post, *w1g, *w1u, *w1d, *gmpre, *gmpost, *win, *rpb, *poolw, *pools, *wba, *wbp, *wout;
    const float *g2pre, *g2post, *w2g, *w2u, *w2d, *gppre, *gppost, *wpp, *wpg;
    float* out; unsigned char* ws;
};

__device__ __forceinline__ unsigned f2bf(float f) { unsigned u = __builtin_bit_cast(unsigned, f); return (u + 0x7fffu + ((u >> 16) & 1u)) >> 16; }
__device__ __forceinline__ unsigned pk2(float lo, float hi) { return f2bf(lo) | (f2bf(hi) << 16); }
__device__ __forceinline__ float bf2f(unsigned b) { return __builtin_bit_cast(float, b << 16); }
__device__ __forceinline__ float bflo(unsigned w) { return __builtin_bit_cast(float, w << 16); }
__device__ __forceinline__ float bfhi(unsigned w) { return __builtin_bit_cast(float, w & 0xffff0000u); }
__device__ __forceinline__ float sigmoidf_(float v) { return 1.0f / (1.0f + __expf(-v)); }
__device__ __forceinline__ float wave_sum(float v) {
#pragma unroll
    for (int o = 1; o < 64; o <<= 1) v += __shfl_xor(v, o);
    return v;
}

__device__ __forceinline__ void transpose_item(const float* src_lane, int ldsrc, const float* gk, int K, bf16* dst_n0, int k0, LAS float* scr, int lane) {
#pragma unroll 8
    for (int i = 0; i < 32; ++i) { const int kk = 2 * i + (lane >> 5); float v = src_lane[(size_t)(k0 + kk) * ldsrc]; if (gk) v *= gk[k0 + kk]; scr[kk * 33 + (lane & 31)] = v; }
    __builtin_amdgcn_s_waitcnt(0xC07F); asm volatile("" ::: "memory");
    const int c = lane & 7;
#pragma unroll
    for (int j = 0; j < 4; ++j) { const int n = (lane >> 3) + 8 * j; const LAS float* s = scr + (8 * c) * 33 + n;
        u32x4 o; o.x = pk2(s[0 * 33], s[1 * 33]); o.y = pk2(s[2 * 33], s[3 * 33]); o.z = pk2(s[4 * 33], s[5 * 33]); o.w = pk2(s[6 * 33], s[7 * 33]);
        *(u32x4*)(dst_n0 + (size_t)n * K + k0 + 8 * c) = o; }
    __builtin_amdgcn_s_waitcnt(0xC07F); asm volatile("" ::: "memory");
}
__device__ __forceinline__ void transpose_plain(const float* W, int K, int N, const float* gk, bf16* dst, LAS float* scr, int gw, int ngw, int lane) {
    const int nblk = N / 32, nitems = (K / 64) * nblk;
    for (int it = gw; it < nitems; it += ngw) { const int kb = it / nblk, nb = it % nblk;
        transpose_item(W + nb * 32 + (lane & 31), N, gk, K, dst + (size_t)(nb * 32) * K, kb * 64, scr, lane); }
}
__device__ __forceinline__ void transpose_gu(const float* Wg, const float* Wu, const float* gk, bf16* dst, LAS float* scr, int gw, int ngw, int lane) {
    const int nblk = NGU / 32, nitems = (DM / 64) * nblk;
    for (int it = gw; it < nitems; it += ngw) { const int kb = it / nblk, nb = it % nblk; const int w = lane & 31;
        const float* src = (w < 16 ? Wg : Wu) + nb * 16 + (w & 15);
        transpose_item(src, DFF, gk, DM, dst + (size_t)(nb * 32) * DM, kb * 64, scr, lane); }
}
__device__ void ph_prologue(const P& p, LAS unsigned char* lds) {
    const int tid = threadIdx.x, lane = tid & 63, wave = tid >> 6;
    LAS float* scr = (LAS float*)(lds + wave * 16384);
    const int gw = blockIdx.x * NWAVES + wave, ngw = gridDim.x * NWAVES;
    unsigned char* ws = p.ws;
    transpose_gu(p.w1g, p.w1u, p.g1pre, (bf16*)(ws + WS_W1GU), scr, gw, ngw, lane);
    transpose_plain(p.w1d, DFF, DM, nullptr, (bf16*)(ws + WS_W1D), scr, gw, ngw, lane);
    transpose_plain(p.win, DM, DIN, p.gmpre, (bf16*)(ws + WS_WIN), scr, gw, ngw, lane);
    transpose_plain(p.wba, DATT, DM, nullptr, (bf16*)(ws + WS_WBA), scr, gw, ngw, lane);
    transpose_plain(p.wout, DM, DM, nullptr, (bf16*)(ws + WS_WOUT), scr, gw, ngw, lane);
    transpose_gu(p.w2g, p.w2u, p.g2pre, (bf16*)(ws + WS_W2GU), scr, gw, ngw, lane);
    transpose_plain(p.w2d, DFF, DM, nullptr, (bf16*)(ws + WS_W2D), scr, gw, ngw, lane);
    transpose_plain(p.wpg, DM, DM, p.gppre, (bf16*)(ws + WS_WPG), scr, gw, ngw, lane);
    transpose_plain(p.wpp, PLE, DM, nullptr, (bf16*)(ws + WS_WPP), scr, gw, ngw, lane);
    bf16* wc = (bf16*)(ws + WS_WCOMB);
    for (int idx = blockIdx.x * NT + tid; idx < DPOOL * DM; idx += gridDim.x * NT) {
        const int n = idx & (DM - 1), k = idx >> 10, g = k >> 7, kl = k & 127;
        const float* pw = p.poolw + ((size_t)g * 128 + kl) * 128; const float* ps = p.pools + g * 128; const float* wb = p.wbp + (size_t)(g * 128) * DM + n;
        float s = 0.f;
        for (int j = 0; j < 128; ++j) s += pw[j] * ps[j] * wb[(size_t)j * DM];
        wc[(size_t)n * DPOOL + k] = (bf16)f2bf(s);
    }
}

__device__ __forceinline__ void row_load(const float* row, int lane, f32x4 (&v)[4]) {
#pragma unroll
    for (int j = 0; j < 4; ++j) v[j] = *((const f32x4*)row + lane + 64 * j);
}
__device__ __forceinline__ float row_ss(const f32x4 (&v)[4]) {
    float s = 0.f;
#pragma unroll
    for (int j = 0; j < 4; ++j) s += (v[j].x * v[j].x + v[j].y * v[j].y) + (v[j].z * v[j].z + v[j].w * v[j].w);
    return wave_sum(s);
}
__device__ __forceinline__ void row_store_bf16(bf16* row, int lane, const f32x4 (&v)[4], float sc) {
#pragma unroll
    for (int j = 0; j < 4; ++j) { u32x2 w; w.x = pk2(v[j].x * sc, v[j].y * sc); w.y = pk2(v[j].z * sc, v[j].w * sc); *((u32x2*)row + lane + 64 * j) = w; }
}
__device__ void ph_norm_in(const float* x, bf16* u) {
    const int lane = threadIdx.x & 63, gw = blockIdx.x * NWAVES + (threadIdx.x >> 6), ngw = gridDim.x * NWAVES;
    for (int r = gw; r < M; r += ngw) { f32x4 v[4]; row_load(x + (size_t)r * DM, lane, v);
        const float rs = rsqrtf(row_ss(v) * (1.0f / DM) + EPS); row_store_bf16(u + (size_t)r * DM, lane, v, rs); }
}
__device__ void ph_norm_res(const float* f, const float* hin, const float* g, float scale, float* hout, bf16* u) {
    const int lane = threadIdx.x & 63, gw = blockIdx.x * NWAVES + (threadIdx.x >> 6), ngw = gridDim.x * NWAVES;
    f32x4 gv[4]; row_load(g, lane, gv);
    for (int r = gw; r < M; r += ngw) { f32x4 v[4], h[4]; row_load(f + (size_t)r * DM, lane, v); row_load(hin + (size_t)r * DM, lane, h);
        const float rs = rsqrtf(row_ss(v) * (1.0f / DM) + EPS) * scale;
#pragma unroll
        for (int j = 0; j < 4; ++j) { h[j] = h[j] + v[j] * gv[j] * rs; *((f32x4*)(hout + (size_t)r * DM) + lane + 64 * j) = h[j]; }
        if (u) { const float r2 = rsqrtf(row_ss(h) * (1.0f / DM) + EPS); row_store_bf16(u + (size_t)r * DM, lane, h, r2); }
    }
}
__device__ void ph_cvt_p(const float* p, bf16* o) {
    for (size_t i = (size_t)blockIdx.x * NT + threadIdx.x; i < (size_t)M * PLE / 4; i += (size_t)gridDim.x * NT) {
        const f32x4 v = *((const f32x4*)p + i); u32x2 w; w.x = pk2(v.x, v.y); w.y = pk2(v.z, v.w); *((u32x2*)o + i) = w; }
}

struct Unit { int pm, pn; };
struct Gemm { const bf16* A; const bf16* Bt; int M, N, K; };
template <class Epi>
__device__ __forceinline__ void gemm_simple(LAS unsigned char* lds, const Gemm g, const Epi& E) {
    const int tid = threadIdx.x, wid = tid >> 6, lane = tid & 63, wr = wid >> 2, wc = wid & 3, fr = lane & 15, fq = lane >> 4;
    constexpr int RS = 144;
    LAS unsigned char* sA = lds; LAS unsigned char* sB = lds + 256 * RS;
    const int nN = g.N / 256, nU = (g.M / 256) * nN;
    for (int unit = blockIdx.x; unit < nU; unit += gridDim.x) {
        Unit u; u.pm = unit / nN; u.pn = unit % nN;
        f32x4 acc[2][2][4][2];
#pragma unroll
        for (int a = 0; a < 2; ++a)
#pragma unroll
            for (int b = 0; b < 2; ++b)
#pragma unroll
                for (int m = 0; m < 4; ++m)
#pragma unroll
                    for (int n = 0; n < 2; ++n) acc[a][b][m][n] = (f32x4){0.f, 0.f, 0.f, 0.f};
        const bf16* Ab = g.A + (size_t)u.pm * 256 * g.K; const bf16* Bb = g.Bt + (size_t)u.pn * 256 * g.K;
        for (int k0 = 0; k0 < g.K; k0 += 64) {
#pragma unroll
            for (int i = 0; i < 4; ++i) { const int ch = tid + NT * i, row = ch >> 3, cc = ch & 7;
                const u32x4 va = *(const u32x4*)(Ab + (size_t)row * g.K + k0 + cc * 8); const u32x4 vb = *(const u32x4*)(Bb + (size_t)row * g.K + k0 + cc * 8);
                *(LAS u32x4*)(sA + row * RS + cc * 16) = va; *(LAS u32x4*)(sB + row * RS + cc * 16) = vb; }
            __syncthreads();
#pragma unroll
            for (int ks = 0; ks < 2; ++ks) {
                bf16x8 At[2][4], Bf[2][2];
#pragma unroll
                for (int ai = 0; ai < 2; ++ai)
#pragma unroll
                    for (int m = 0; m < 4; ++m) At[ai][m] = *(const LAS bf16x8*)(sA + (128 * ai + 64 * wr + 16 * m + fr) * RS + ks * 64 + fq * 16);
#pragma unroll
                for (int bj = 0; bj < 2; ++bj)
#pragma unroll
                    for (int n = 0; n < 2; ++n) Bf[bj][n] = *(const LAS bf16x8*)(sB + (128 * bj + 32 * wc + 16 * n + fr) * RS + ks * 64 + fq * 16);
#pragma unroll
                for (int ai = 0; ai < 2; ++ai)
#pragma unroll
                    for (int bj = 0; bj < 2; ++bj)
#pragma unroll
                        for (int m = 0; m < 4; ++m)
#pragma unroll
                            for (int n = 0; n < 2; ++n) acc[ai][bj][m][n] = __builtin_amdgcn_mfma_f32_16x16x32_bf16(Bf[bj][n], At[ai][m], acc[ai][bj][m][n], 0, 0, 0);
            }
            __syncthreads();
        }
        E(acc, u, wr, wc, fr, fq);
    }
}

#define EPI_LOOP_BEGIN \
    _Pragma("unroll") for (int ai = 0; ai < 2; ++ai) _Pragma("unroll") for (int m = 0; m < 4; ++m) { const int row = u.pm * 256 + ai * 128 + wr * 64 + m * 16 + fr; \
    _Pragma("unroll") for (int bj = 0; bj < 2; ++bj)
struct EpiSwiglu {
    bf16* O;
    __device__ __forceinline__ void operator()(const f32x4 (&acc)[2][2][4][2], const Unit& u, int wr, int wc, int fr, int fq) const {
        EPI_LOOP_BEGIN { const int col = u.pn * 128 + bj * 64 + wc * 16 + 4 * fq; const f32x4 G = acc[ai][bj][m][0], U = acc[ai][bj][m][1]; float o[4];
#pragma unroll
            for (int i = 0; i < 4; ++i) o[i] = G[i] * sigmoidf_(G[i]) * U[i];
            u32x2 w; w.x = pk2(o[0], o[1]); w.y = pk2(o[2], o[3]); *(u32x2*)(O + (size_t)row * DFF + col) = w; } }
    }
};
struct EpiStoreF32 {
    float* C; int ldc;
    __device__ __forceinline__ void operator()(const f32x4 (&acc)[2][2][4][2], const Unit& u, int wr, int wc, int fr, int fq) const {
        EPI_LOOP_BEGIN {
#pragma unroll
            for (int n = 0; n < 2; ++n) { const int col = u.pn * 256 + bj * 128 + wc * 32 + n * 16 + 4 * fq; *(f32x4*)(C + (size_t)row * ldc + col) = acc[ai][bj][m][n]; } } }
    }
};
struct EpiStoreBf16 {
    bf16* C; int ldc;
    __device__ __forceinline__ void operator()(const f32x4 (&acc)[2][2][4][2], const Unit& u, int wr, int wc, int fr, int fq) const {
        EPI_LOOP_BEGIN {
#pragma unroll
            for (int n = 0; n < 2; ++n) { const int col = u.pn * 256 + bj * 128 + wc * 32 + n * 16 + 4 * fq; const f32x4 v = acc[ai][bj][m][n];
                u32x2 w; w.x = pk2(v[0], v[1]); w.y = pk2(v[2], v[3]); *(u32x2*)(C + (size_t)row * ldc + col) = w; } } }
    }
};
struct EpiGateMul {
    const bf16* gate; int ldg; bf16* T;
    __device__ __forceinline__ void operator()(const f32x4 (&acc)[2][2][4][2], const Unit& u, int wr, int wc, int fr, int fq) const {
        EPI_LOOP_BEGIN {
#pragma unroll
            for (int n = 0; n < 2; ++n) { const int col = u.pn * 256 + bj * 128 + wc * 32 + n * 16 + 4 * fq; const f32x4 v = acc[ai][bj][m][n];
                const u32x2 gw = *(const u32x2*)(gate + (size_t)row * ldg + col);
                const float o0 = sigmoidf_(bflo(gw.x)) * v[0], o1 = sigmoidf_(bfhi(gw.x)) * v[1], o2 = sigmoidf_(bflo(gw.y)) * v[2], o3 = sigmoidf_(bfhi(gw.y)) * v[3];
                u32x2 w; w.x = pk2(o0, o1); w.y = pk2(o2, o3); *(u32x2*)(T + (size_t)row * DM + col) = w; } } }
    }
};
struct EpiGateAdd {
    const bf16* gate; int ldg; const bf16* T; bf16* Mg;
    __device__ __forceinline__ void operator()(const f32x4 (&acc)[2][2][4][2], const Unit& u, int wr, int wc, int fr, int fq) const {
        EPI_LOOP_BEGIN {
#pragma unroll
            for (int n = 0; n < 2; ++n) { const int col = u.pn * 256 + bj * 128 + wc * 32 + n * 16 + 4 * fq; const f32x4 v = acc[ai][bj][m][n];
                const u32x2 gw = *(const u32x2*)(gate + (size_t)row * ldg + col); const u32x2 tw = *(const u32x2*)(T + (size_t)row * DM + col);
                const float o0 = bflo(tw.x) + sigmoidf_(bflo(gw.x)) * v[0], o1 = bfhi(tw.x) + sigmoidf_(bfhi(gw.x)) * v[1], o2 = bflo(tw.y) + sigmoidf_(bflo(gw.y)) * v[2], o3 = bfhi(tw.y) + sigmoidf_(bfhi(gw.y)) * v[3];
                u32x2 w; w.x = pk2(o0, o1); w.y = pk2(o2, o3); *(u32x2*)(Mg + (size_t)row * DM + col) = w; } } }
    }
};
struct EpiPle {
    const float* T2; float* E;
    __device__ __forceinline__ void operator()(const f32x4 (&acc)[2][2][4][2], const Unit& u, int wr, int wc, int fr, int fq) const {
        EPI_LOOP_BEGIN {
#pragma unroll
            for (int n = 0; n < 2; ++n) { const int col = u.pn * 256 + bj * 128 + wc * 32 + n * 16 + 4 * fq; const f32x4 v = acc[ai][bj][m][n];
                const f32x4 t = *(const f32x4*)(T2 + (size_t)row * DM + col); f32x4 o;
#pragma unroll
                for (int i = 0; i < 4; ++i) o[i] = t[i] * sigmoidf_(v[i]);
                *(f32x4*)(E + (size_t)row * DM + col) = o; } } }
    }
};

__device__ __forceinline__ void ld8(const bf16* p, float (&d)[8]) { const u32x4 w = *(const u32x4*)p; d[0] = bflo(w.x); d[1] = bfhi(w.x); d[2] = bflo(w.y); d[3] = bfhi(w.y); d[4] = bflo(w.z); d[5] = bfhi(w.z); d[6] = bflo(w.w); d[7] = bfhi(w.w); }
__device__ void ph_attn_v0(const bf16* proj, const float* rpb, bf16* ao) {
    for (int idx = blockIdx.x * NT + threadIdx.x; idx < M * NH; idx += gridDim.x * NT) {
        const int h = idx >> 15, t = idx & (M - 1), b = t >> 12, s = t & 4095, r = s >> 6, c = s & 63;
        int rs = r - 4; rs = rs < 0 ? 0 : (rs > 56 ? 56 : rs);
        int cs = c - 8; cs = cs < 0 ? 0 : (cs > 48 ? 48 : cs);
        float q[64], o[64];
#pragma unroll
        for (int d = 0; d < 8; ++d) { float tmp[8]; ld8(proj + (size_t)t * DIN + h * 64 + d * 8, tmp);
#pragma unroll
            for (int e = 0; e < 8; ++e) { q[d * 8 + e] = tmp[e] * 0.125f; o[d * 8 + e] = 0.f; } }
        float mx = -1e30f, l = 0.f;
        for (int i = 0; i < 8; ++i) {
            const int kr = rs + i, dr = kr - r + 7;
            const bf16* kbase = proj + ((size_t)(b << 12) + (kr << 6) + cs) * DIN + 512 + h * 64;
            const float* bias = rpb + ((size_t)h * 15 + dr) * 31 + (cs - c + 15);
#pragma unroll 1
            for (int j = 0; j < 16; ++j) { float a = 0.f;
#pragma unroll
                for (int d = 0; d < 8; ++d) { float kk[8]; ld8(kbase + (size_t)j * DIN + d * 8, kk);
#pragma unroll
                    for (int e = 0; e < 8; ++e) a += q[d * 8 + e] * kk[e]; }
                a += bias[j];
                const float mn = fmaxf(mx, a), corr = __expf(mx - mn), pj = __expf(a - mn); mx = mn; l = l * corr + pj;
#pragma unroll
                for (int d = 0; d < 8; ++d) { float vv[8]; ld8(kbase + 512 + (size_t)j * DIN + d * 8, vv);
#pragma unroll
                    for (int e = 0; e < 8; ++e) o[d * 8 + e] = o[d * 8 + e] * corr + pj * vv[e]; } }
        }
        const float inv = 1.0f / l;
#pragma unroll
        for (int d = 0; d < 8; ++d) { u32x4 w; w.x = pk2(o[d * 8] * inv, o[d * 8 + 1] * inv); w.y = pk2(o[d * 8 + 2] * inv, o[d * 8 + 3] * inv); w.z = pk2(o[d * 8 + 4] * inv, o[d * 8 + 5] * inv); w.w = pk2(o[d * 8 + 6] * inv, o[d * 8 + 7] * inv);
            *(u32x4*)(ao + (size_t)t * DATT + h * 64 + d * 8) = w; }
    }
}
__device__ void ph_pool_v0(const bf16* proj, bf16* pooled) {
    for (int idx = blockIdx.x * NT + threadIdx.x; idx < M * (DPOOL / 8); idx += gridDim.x * NT) {
        const int t = idx >> 6, c8 = idx & 63, ch = c8 * 8, g = ch >> 7, half = 1 << g, b = t >> 12, s = t & 4095;
        const int lo = (s - half) < 0 ? 0 : s - half, hi = (s + half) > SEQ ? SEQ : s + half;
        float acc[8] = {0.f, 0.f, 0.f, 0.f, 0.f, 0.f, 0.f, 0.f};
        for (int ss = lo; ss < hi; ++ss) { float v[8]; ld8(proj + ((size_t)(b << 12) + ss) * DIN + 1536 + ch, v);
#pragma unroll
            for (int e = 0; e < 8; ++e) acc[e] += v[e]; }
        float own[8]; ld8(proj + (size_t)t * DIN + 1536 + ch, own); const float inv = 1.0f / (float)(hi - lo);
        u32x4 w; w.x = pk2(acc[0] * inv - own[0], acc[1] * inv - own[1]); w.y = pk2(acc[2] * inv - own[2], acc[3] * inv - own[3]);
        w.z = pk2(acc[4] * inv - own[4], acc[5] * inv - own[5]); w.w = pk2(acc[6] * inv - own[6], acc[7] * inv - own[7]);
        *(u32x4*)(pooled + (size_t)t * DPOOL + ch) = w;
    }
}

constexpr int LDS_BYTES = 131072;
template <int PH>
__global__ void __launch_bounds__(NT) phase_kernel(P p) {
    extern __shared__ __attribute__((aligned(16))) unsigned char lds_raw[];
    LAS unsigned char* lds = (LAS unsigned char*)lds_raw;
    unsigned char* ws = p.ws;
    bf16* U = (bf16*)(ws + WS_U);
    if constexpr (PH == 0) ph_prologue(p, lds);
    if constexpr (PH == 1) ph_norm_in(p.x, U);
    if constexpr (PH == 2) { Gemm g{U, (const bf16*)(ws + WS_W1GU), M, NGU, DM}; EpiSwiglu E{(bf16*)(ws + WS_R1)}; gemm_simple(lds, g, E); }
    if constexpr (PH == 3) { Gemm g{(const bf16*)(ws + WS_R1), (const bf16*)(ws + WS_W1D), M, DM, DFF}; EpiStoreF32 E{(float*)(ws + WS_R2), DM}; gemm_simple(lds, g, E); }
    if constexpr (PH == 4) ph_norm_res((const float*)(ws + WS_R2), p.x, p.g1post, 0.5f, p.out, U);
    if constexpr (PH == 5) { Gemm g{U, (const bf16*)(ws + WS_WIN), M, DIN, DM}; EpiStoreBf16 E{(bf16*)(ws + WS_R1), DIN}; gemm_simple(lds, g, E); }
    if constexpr (PH == 6) ph_attn_v0((const bf16*)(ws + WS_R1), p.rpb, (bf16*)(ws + WS_ATT));
    if constexpr (PH == 7) ph_pool_v0((const bf16*)(ws + WS_R1), (bf16*)(ws + WS_POOLED));
    if constexpr (PH == 8) { Gemm g{(const bf16*)(ws + WS_ATT), (const bf16*)(ws + WS_WBA), M, DM, DATT}; EpiGateMul E{(const bf16*)(ws + WS_R1) + 2048, DIN, (bf16*)(ws + WS_R2)}; gemm_simple(lds, g, E); }
    if constexpr (PH == 9) { Gemm g{(const bf16*)(ws + WS_POOLED), (const bf16*)(ws + WS_WCOMB), M, DM, DPOOL}; EpiGateAdd E{(const bf16*)(ws + WS_R1) + 3072, DIN, (const bf16*)(ws + WS_R2), (bf16*)(ws + WS_MERGED)}; gemm_simple(lds, g, E); }
    if constexpr (PH == 10) { Gemm g{(const bf16*)(ws + WS_MERGED), (const bf16*)(ws + WS_WOUT), M, DM, DM}; EpiStoreF32 E{(float*)(ws + WS_R1), DM}; gemm_simple(lds, g, E); }
    if constexpr (PH == 11) ph_norm_res((const float*)(ws + WS_R1), p.out, p.gmpost, 1.0f, p.out, U);
    if constexpr (PH == 12) { Gemm g{U, (const bf16*)(ws + WS_W2GU), M, NGU, DM}; EpiSwiglu E{(bf16*)(ws + WS_R1)}; gemm_simple(lds, g, E); }
    if constexpr (PH == 13) { Gemm g{(const bf16*)(ws + WS_R1), (const bf16*)(ws + WS_W2D), M, DM, DFF}; EpiStoreF32 E{(float*)(ws + WS_R2), DM}; gemm_simple(lds, g, E); }
    if constexpr (PH == 14) { ph_norm_res((const float*)(ws + WS_R2), p.out, p.g2post, 0.5f, p.out, U); ph_cvt_p(p.p, (bf16*)(ws + WS_R1)); }
    if constexpr (PH == 15) { Gemm g{(const bf16*)(ws + WS_R1), (const bf16*)(ws + WS_WPP), M, DM, PLE}; EpiStoreF32 E{(float*)(ws + WS_T2), DM}; gemm_simple(lds, g, E); }
    if constexpr (PH == 16) { Gemm g{U, (const bf16*)(ws + WS_WPG), M, DM, DM}; EpiPle E{(const float*)(ws + WS_T2), (float*)(ws + WS_R2)}; gemm_simple(lds, g, E); }
    if constexpr (PH == 17) ph_norm_res((const float*)(ws + WS_R2), p.out, p.gppost, 1.0f, p.out, nullptr);
}

template <int PH> static void launch_phase(const P& p, hipStream_t stream) {
    static bool attr = false;
    if (!attr) { (void)hipFuncSetAttribute((const void*)phase_kernel<PH>, hipFuncAttributeMaxDynamicSharedMemorySize, LDS_BYTES); attr = true; }
    hipLaunchKernelGGL(phase_kernel<PH>, dim3(256), dim3(NT), LDS_BYTES, stream, p);
}

extern "C" void kernel_launch(void* const* d_in, const int* in_sizes, int n_in, void* d_out, int out_size, void* d_ws, size_t ws_size, hipStream_t stream) {
    if (n_in != 25 || out_size != M * DM || ws_size < 512 * MiB) { fprintf(stderr, "kernel_launch: unexpected shapes n_in %d out %d ws %zu\n", n_in, out_size, ws_size); return; }
    P p{};
    const float** f = (const float**)&p;
    for (int i = 0; i < 25; ++i) f[i] = (const float*)d_in[i];
    p.out = (float*)d_out; p.ws = (unsigned char*)d_ws;
    launch_phase<0>(p, stream); launch_phase<1>(p, stream); launch_phase<2>(p, stream); launch_phase<3>(p, stream); launch_phase<4>(p, stream); launch_phase<5>(p, stream);
    launch_phase<6>(p, stream); launch_phase<7>(p, stream); launch_phase<8>(p, stream); launch_phase<9>(p, stream); launch_phase<10>(p, stream); launch_phase<11>(p, stream);
    launch_phase<12>(p, stream); launch_phase<13>(p, stream); launch_phase<14>(p, stream); launch_phase<15>(p, stream); launch_phase<16>(p, stream); launch_phase<17>(p, stream);
}
```

```cpp
#include <hip/hip_runtime.h>
#include <cstdint>
#include <cstdio>

#define LAS __attribute__((address_space(3)))
typedef unsigned short bf16;
typedef short bf16x8 __attribute__((ext_vector_type(8)));
typedef float f32x4 __attribute__((ext_vector_type(4)));
typedef unsigned u32x4 __attribute__((ext_vector_type(4)));
typedef unsigned u32x2 __attribute__((ext_vector_type(2)));

constexpr int BATCH = 8, SEQ = 4096, DM = 1024, M = BATCH * SEQ, DFF = 2816, NGU = 2 * DFF, DIN = 4096;
constexpr int DATT = 512, DPOOL = 512, PLE = 256, NH = 8, HD = 64;
constexpr float EPS = 1e-6f;
constexpr int NT = 512, NWAVES = 8;

constexpr size_t MiB = 1u << 20;
constexpr size_t WS_W1GU = 1 * MiB, WS_W1D = 12 * MiB, WS_WIN = 18 * MiB, WS_WBA = 26 * MiB, WS_WCOMB = 27 * MiB, WS_WOUT = 28 * MiB;
constexpr size_t WS_W2GU = 30 * MiB, WS_W2D = 41 * MiB, WS_WPG = 47 * MiB, WS_WPP = 49 * MiB;
constexpr size_t WS_U = 64 * MiB;
constexpr size_t WS_ATT = 64 * MiB, WS_POOLED = 96 * MiB;
constexpr size_t WS_R1 = 128 * MiB;
constexpr size_t WS_T2 = 256 * MiB;
constexpr size_t WS_R2 = 384 * MiB;
constexpr size_t WS_MERGED = 448 * MiB;

struct P {
    const float *x, *p, *g1pre, *g1post, *w1g, *w1u, *w1d, *gmpre, *gmpost, *win, *rpb, *poolw, *pools, *wba, *wbp, *wout;
    const float *g2pre, *g2post, *w2g, *w2u, *w2d, *gppre, *gppost, *wpp, *wpg;
    float* out; unsigned char* ws;
};

__device__ __forceinline__ unsigned f2bf(float f) { unsigned u = __builtin_bit_cast(unsigned, f); return (u + 0x7fffu + ((u >> 16) & 1u)) >> 16; }
__device__ __forceinline__ unsigned pk2(float lo, float hi) { return f2bf(lo) | (f2bf(hi) << 16); }
__device__ __forceinline__ float bf2f(unsigned b) { return __builtin_bit_cast(float, b << 16); }
__device__ __forceinline__ float bflo(unsigned w) { return __builtin_bit_cast(float, w << 16); }
__device__ __forceinline__ float bfhi(unsigned w) { return __builtin_bit_cast(float, w & 0xffff0000u); }
__device__ __forceinline__ float sigmoidf_(float v) { return 1.0f / (1.0f + __expf(-v)); }
__device__ __forceinline__ float wave_sum(float v) {
#pragma unroll
    for (int o = 1; o < 64; o <<= 1) v += __shfl_xor(v, o);
    return v;
}

__device__ __forceinline__ void transpose_item(const float* src_lane, int ldsrc, const float* gk, int K, bf16* dst_n0, int k0, LAS float* scr, int lane) {
#pragma unroll 8
    for (int i = 0; i < 32; ++i) { const int kk = 2 * i + (lane >> 5); float v = src_lane[(size_t)(k0 + kk) * ldsrc]; if (gk) v *= gk[k0 + kk]; scr[kk * 33 + (lane & 31)] = v; }
    __builtin_amdgcn_s_waitcnt(0xC07F); asm volatile("" ::: "memory");
    const int c = lane & 7;
#pragma unroll
    for (int j = 0; j < 4; ++j) { const int n = (lane >> 3) + 8 * j; const LAS float* s = scr + (8 * c) * 33 + n;
        u32x4 o; o.x = pk2(s[0 * 33], s[1 * 33]); o.y = pk2(s[2 * 33], s[3 * 33]); o.z = pk2(s[4 * 33], s[5 * 33]); o.w = pk2(s[6 * 33], s[7 * 33]);
        *(u32x4*)(dst_n0 + (size_t)n * K + k0 + 8 * c) = o; }
    __builtin_amdgcn_s_waitcnt(0xC07F); asm volatile("" ::: "memory");
}
__device__ __forceinline__ void transpose_plain(const float* W, int K, int N, const float* gk, bf16* dst, LAS float* scr, int gw, int ngw, int lane) {
    const int nblk = N / 32, nitems = (K / 64) * nblk;
    for (int it = gw; it < nitems; it += ngw) { const int kb = it / nblk, nb = it % nblk;
        transpose_item(W + nb * 32 + (lane & 31), N, gk, K, dst + (size_t)(nb * 32) * K, kb * 64, scr, lane); }
}
__device__ __forceinline__ void transpose_gu(const float* Wg, const float* Wu, const float* gk, bf16* dst, LAS float* scr, int gw, int ngw, int lane) {
    const int nblk = NGU / 32, nitems = (DM / 64) * nblk;
    for (int it = gw; it < nitems; it += ngw) { const int kb = it / nblk, nb = it % nblk; const int w = lane & 31;
        const float* src = (w < 16 ? Wg : Wu) + nb * 16 + (w & 15);
        transpose_item(src, DFF, gk, DM, dst + (size_t)(nb * 32) * DM, kb * 64, scr, lane); }
}
__device__ void ph_prologue(const P& p, LAS unsigned char* lds) {
    const int tid = threadIdx.x, lane = tid & 63, wave = tid >> 6;
    LAS float* scr = (LAS float*)(lds + wave * 16384);
    const int gw = blockIdx.x * NWAVES + wave, ngw = gridDim.x * NWAVES;
    unsigned char* ws = p.ws;
    transpose_gu(p.w1g, p.w1u, p.g1pre, (bf16*)(ws + WS_W1GU), scr, gw, ngw, lane);
    transpose_plain(p.w1d, DFF, DM, nullptr, (bf16*)(ws + WS_W1D), scr, gw, ngw, lane);
    transpose_plain(p.win, DM, DIN, p.gmpre, (bf16*)(ws + WS_WIN), scr, gw, ngw, lane);
    transpose_plain(p.wba, DATT, DM, nullptr, (bf16*)(ws + WS_WBA), scr, gw, ngw, lane);
    transpose_plain(p.wout, DM, DM, nullptr, (bf16*)(ws + WS_WOUT), scr, gw, ngw, lane);
    transpose_gu(p.w2g, p.w2u, p.g2pre, (bf16*)(ws + WS_W2GU), scr, gw, ngw, lane);
    transpose_plain(p.w2d, DFF, DM, nullptr, (bf16*)(ws + WS_W2D), scr, gw, ngw, lane);
    transpose_plain(p.wpg, DM, DM, p.gppre, (bf16*)(ws + WS_WPG), scr, gw, ngw, lane);
    transpose_plain(p.wpp, PLE, DM, nullptr, (bf16*)(ws + WS_WPP), scr, gw, ngw, lane);
    bf16* wc = (bf16*)(ws + WS_WCOMB);
    for (int idx = blockIdx.x * NT + tid; idx < DPOOL * DM; idx += gridDim.x * NT) {
        const int n = idx & (DM - 1), k = idx >> 10, g = k >> 7, kl = k & 127;
        const float* pw = p.poolw + ((size_t)g * 128 + kl) * 128; const float* ps = p.pools + g * 128; const float* wb = p.wbp + (size_t)(g * 128) * DM + n;
        float s = 0.f;
        for (int j = 0; j < 128; ++j) s += pw[j] * ps[j] * wb[(size_t)j * DM];
        wc[(size_t)n * DPOOL + k] = (bf16)f2bf(s);
    }
}

__device__ __forceinline__ void row_load(const float* row, int lane, f32x4 (&v)[4]) {
#pragma unroll
    for (int j = 0; j < 4; ++j) v[j] = *((const f32x4*)row + lane + 64 * j);
}
__device__ __forceinline__ float row_ss(const f32x4 (&v)[4]) {
    float s = 0.f;
#pragma unroll
    for (int j = 0; j < 4; ++j) s += (v[j].x * v[j].x + v[j].y * v[j].y) + (v[j].z * v[j].z + v[j].w * v[j].w);
    return wave_sum(s);
}
__device__ __forceinline__ void row_store_bf16(bf16* row, int lane, const f32x4 (&v)[4], float sc) {
#pragma unroll
    for (int j = 0; j < 4; ++j) { u32x2 w; w.x = pk2(v[j].x * sc, v[j].y * sc); w.y = pk2(v[j].z * sc, v[j].w * sc); *((u32x2*)row + lane + 64 * j) = w; }
}
__device__ void ph_norm_in(const float* x, bf16* u) {
    const int lane = threadIdx.x & 63, gw = blockIdx.x * NWAVES + (threadIdx.x >> 6), ngw = gridDim.x * NWAVES;
    for (int r = gw; r < M; r += ngw) { f32x4 v[4]; row_load(x + (size_t)r * DM, lane, v);
        const float rs = rsqrtf(row_ss(v) * (1.0f / DM) + EPS); row_store_bf16(u + (size_t)r * DM, lane, v, rs); }
}
__device__ void ph_norm_res(const float* f, const float* hin, const float* g, float scale, float* hout, bf16* u) {
    const int lane = threadIdx.x & 63, gw = blockIdx.x * NWAVES + (threadIdx.x >> 6), ngw = gridDim.x * NWAVES;
    f32x4 gv[4]; row_load(g, lane, gv);
    for (int r = gw; r < M; r += ngw) { f32x4 v[4], h[4]; row_load(f + (size_t)r * DM, lane, v); row_load(hin + (size_t)r * DM, lane, h);
        const float rs = rsqrtf(row_ss(v) * (1.0f / DM) + EPS) * scale;
#pragma unroll
        for (int j = 0; j < 4; ++j) { h[j] = h[j] + v[j] * gv[j] * rs; *((f32x4*)(hout + (size_t)r * DM) + lane + 64 * j) = h[j]; }
        if (u) { const float r2 = rsqrtf(row_ss(h) * (1.0f / DM) + EPS); row_store_bf16(u + (size_t)r * DM, lane, h, r2); }
    }
}
__device__ void ph_cvt_p(const float* p, bf16* o) {
    for (size_t i = (size_t)blockIdx.x * NT + threadIdx.x; i < (size_t)M * PLE / 4; i += (size_t)gridDim.x * NT) {
        const f32x4 v = *((const f32x4*)p + i); u32x2 w; w.x = pk2(v.x, v.y); w.y = pk2(v.z, v.w); *((u32x2*)o + i) = w; }
}

struct Unit { int pm, pn; };
struct Gemm { const bf16* A; const bf16* Bt; int M, N, K; };
template <class Epi>
__device__ __forceinline__ void gemm_simple(LAS unsigned char* lds, const Gemm g, const Epi& E) {
    const int tid = threadIdx.x, wid = tid >> 6, lane = tid & 63, wr = wid >> 2, wc = wid & 3, fr = lane & 15, fq = lane >> 4;
    constexpr int RS = 144;
    LAS unsigned char* sA = lds; LAS unsigned char* sB = lds + 256 * RS;
    const int nN = g.N / 256, nU = (g.M / 256) * nN;
    for (int unit = blockIdx.x; unit < nU; unit += gridDim.x) {
        Unit u; u.pm = unit / nN; u.pn = unit % nN;
        f32x4 acc[2][2][4][2];
#pragma unroll
        for (int a = 0; a < 2; ++a)
#pragma unroll
            for (int b = 0; b < 2; ++b)
#pragma unroll
                for (int m = 0; m < 4; ++m)
#pragma unroll
                    for (int n = 0; n < 2; ++n) acc[a][b][m][n] = (f32x4){0.f, 0.f, 0.f, 0.f};
        const bf16* Ab = g.A + (size_t)u.pm * 256 * g.K; const bf16* Bb = g.Bt + (size_t)u.pn * 256 * g.K;
        for (int k0 = 0; k0 < g.K; k0 += 64) {
#pragma unroll
            for (int i = 0; i < 4; ++i) { const int ch = tid + NT * i, row = ch >> 3, cc = ch & 7;
                const u32x4 va = *(const u32x4*)(Ab + (size_t)row * g.K + k0 + cc * 8); const u32x4 vb = *(const u32x4*)(Bb + (size_t)row * g.K + k0 + cc * 8);
                *(LAS u32x4*)(sA + row * RS + cc * 16) = va; *(LAS u32x4*)(sB + row * RS + cc * 16) = vb; }
            __syncthreads();
#pragma unroll
            for (int ks = 0; ks < 2; ++ks) {
                bf16x8 At[2][4], Bf[2][2];
#pragma unroll
                for (int ai = 0; ai < 2; ++ai)
#pragma unroll
                    for (int m = 0; m < 4; ++m) At[ai][m] = *(const LAS bf16x8*)(sA + (128 * ai + 64 * wr + 16 * m + fr) * RS + ks * 64 + fq * 16);
#pragma unroll
                for (int bj = 0; bj < 2; ++bj)
#pragma unroll
                    for (int n = 0; n < 2; ++n) Bf[bj][n] = *(const LAS bf16x8*)(sB + (128 * bj + 32 * wc + 16 * n + fr) * RS + ks * 64 + fq * 16);
#pragma unroll
                for (int ai = 0; ai < 2; ++ai)
#pragma unroll
                    for (int bj = 0; bj < 2; ++bj)
#pragma unroll
                        for (int m = 0; m < 4; ++m)
#pragma unroll
                            for (int n = 0; n < 2; ++n) acc[ai][bj][m][n] = __builtin_amdgcn_mfma_f32_16x16x32_bf16(Bf[bj][n], At[ai][m], acc[ai][bj][m][n], 0, 0, 0);
            }
            __syncthreads();
        }
        E(acc, u, wr, wc, fr, fq);
    }
}

#define EPI_LOOP_BEGIN \
    _Pragma("unroll") for (int ai = 0; ai < 2; ++ai) _Pragma("unroll") for (int m = 0; m < 4; ++m) { const int row = u.pm * 256 + ai * 128 + wr * 64 + m * 16 + fr; \
    _Pragma("unroll") for (int bj = 0; bj < 2; ++bj)
struct EpiSwiglu {
    bf16* O;
    __device__ __forceinline__ void operator()(const f32x4 (&acc)[2][2][4][2], const Unit& u, int wr, int wc, int fr, int fq) const {
        EPI_LOOP_BEGIN { const int col = u.pn * 128 + bj * 64 + wc * 16 + 4 * fq; const f32x4 G = acc[ai][bj][m][0], U = acc[ai][bj][m][1]; float o[4];
#pragma unroll
            for (int i = 0; i < 4; ++i) o[i] = G[i] * sigmoidf_(G[i]) * U[i];
            u32x2 w; w.x = pk2(o[0], o[1]); w.y = pk2(o[2], o[3]); *(u32x2*)(O + (size_t)row * DFF + col) = w; } }
    }
};
struct EpiStoreF32 {
    float* C; int ldc;
    __device__ __forceinline__ void operator()(const f32x4 (&acc)[2][2][4][2], const Unit& u, int wr, int wc, int fr, int fq) const {
        EPI_LOOP_BEGIN {
#pragma unroll
            for (int n = 0; n < 2; ++n) { const int col = u.pn * 256 + bj * 128 + wc * 32 + n * 16 + 4 * fq; *(f32x4*)(C + (size_t)row * ldc + col) = acc[ai][bj][m][n]; } } }
    }
};
struct EpiStoreBf16 {
    bf16* C; int ldc;
    __device__ __forceinline__ void operator()(const f32x4 (&acc)[2][2][4][2], const Unit& u, int wr, int wc, int fr, int fq) const {
        EPI_LOOP_BEGIN {
#pragma unroll
            for (int n = 0; n < 2; ++n) { const int col = u.pn * 256 + bj * 128 + wc * 32 + n * 16 + 4 * fq; const f32x4 v = acc[ai][bj][m][n];
                u32x2 w; w.x = pk2(v[0], v[1]); w.y = pk2(v[2], v[3]); *(u32x2*)(C + (size_t)row * ldc + col) = w; } } }
    }
};
struct EpiGateMul {
    const bf16* gate; int ldg; bf16* T;
    __device__ __forceinline__ void operator()(const f32x4 (&acc)[2][2][4][2], const Unit& u, int wr, int wc, int fr, int fq) const {
        EPI_LOOP_BEGIN {
#pragma unroll
            for (int n = 0; n < 2; ++n) { const int col = u.pn * 256 + bj * 128 + wc * 32 + n * 16 + 4 * fq; const f32x4 v = acc[ai][bj][m][n];
                const u32x2 gw = *(const u32x2*)(gate + (size_t)row * ldg + col);
                const float o0 = sigmoidf_(bflo(gw.x)) * v[0], o1 = sigmoidf_(bfhi(gw.x)) * v[1], o2 = sigmoidf_(bflo(gw.y)) * v[2], o3 = sigmoidf_(bfhi(gw.y)) * v[3];
                u32x2 w; w.x = pk2(o0, o1); w.y = pk2(o2, o3); *(u32x2*)(T + (size_t)row * DM + col) = w; } } }
    }
};
struct EpiGateAdd {
    const bf16* gate; int ldg; const bf16* T; bf16* Mg;
    __device__ __forceinline__ void operator()(const f32x4 (&acc)[2][2][4][2], const Unit& u, int wr, int wc, int fr, int fq) const {
        EPI_LOOP_BEGIN {
#pragma unroll
            for (int n = 0; n < 2; ++n) { const int col = u.pn * 256 + bj * 128 + wc * 32 + n * 16 + 4 * fq; const f32x4 v = acc[ai][bj][m][n];
                const u32x2 gw = *(const u32x2*)(gate + (size_t)row * ldg + col); const u32x2 tw = *(const u32x2*)(T + (size_t)row * DM + col);
                const float o0 = bflo(tw.x) + sigmoidf_(bflo(gw.x)) * v[0], o1 = bfhi(tw.x) + sigmoidf_(bfhi(gw.x)) * v[1], o2 = bflo(tw.y) + sigmoidf_(bflo(gw.y)) * v[2], o3 = bfhi(tw.y) + sigmoidf_(bfhi(gw.y)) * v[3];
                u32x2 w; w.x = pk2(o0, o1); w.y = pk2(o2, o3); *(u32x2*)(Mg + (size_t)row * DM + col) = w; } } }
    }
};
struct EpiPle {
    const float* T2; float* E;
    __device__ __forceinline__ void operator()(const f32x4 (&acc)[2][2][4][2], const Unit& u, int wr, int wc, int fr, int fq) const {
        EPI_LOOP_BEGIN {
#pragma unroll
            for (int n = 0; n < 2; ++n) { const int col = u.pn * 256 + bj * 128 + wc * 32 + n * 16 + 4 * fq; const f32x4 v = acc[ai][bj][m][n];
                const f32x4 t = *(const f32x4*)(T2 + (size_t)row * DM + col); f32x4 o;
#pragma unroll
                for (int i = 0; i < 4; ++i) o[i] = t[i] * sigmoidf_(v[i]);
                *(f32x4*)(E + (size_t)row * DM + col) = o; } } }
    }
};

__device__ __forceinline__ void ld8(const bf16* p, float (&d)[8]) { const u32x4 w = *(const u32x4*)p; d[0] = bflo(w.x); d[1] = bfhi(w.x); d[2] = bflo(w.y); d[3] = bfhi(w.y); d[4] = bflo(w.z); d[5] = bfhi(w.z); d[6] = bflo(w.w); d[7] = bfhi(w.w); }
__device__ void ph_attn_v0(const bf16* proj, const float* rpb, bf16* ao) {
    for (int idx = blockIdx.x * NT + threadIdx.x; idx < M * NH; idx += gridDim.x * NT) {
        const int h = idx >> 15, t = idx & (M - 1), b = t >> 12, s = t & 4095, r = s >> 6, c = s & 63;
        int rs = r - 4; rs = rs < 0 ? 0 : (rs > 56 ? 56 : rs);
        int cs = c - 8; cs = cs < 0 ? 0 : (cs > 48 ? 48 : cs);
        float q[64], o[64];
#pragma unroll
        for (int d = 0; d < 8; ++d) { float tmp[8]; ld8(proj + (size_t)t * DIN + h * 64 + d * 8, tmp);
#pragma unroll
            for (int e = 0; e < 8; ++e) { q[d * 8 + e] = tmp[e] * 0.125f; o[d * 8 + e] = 0.f; } }
        float mx = -1e30f, l = 0.f;
        for (int i = 0; i < 8; ++i) {
            const int kr = rs + i, dr = kr - r + 7;
            const bf16* kbase = proj + ((size_t)(b << 12) + (kr << 6) + cs) * DIN + 512 + h * 64;
            const float* bias = rpb + ((size_t)h * 15 + dr) * 31 + (cs - c + 15);
#pragma unroll 1
            for (int j = 0; j < 16; ++j) { float a = 0.f;
#pragma unroll
                for (int d = 0; d < 8; ++d) { float kk[8]; ld8(kbase + (size_t)j * DIN + d * 8, kk);
#pragma unroll
                    for (int e = 0; e < 8; ++e) a += q[d * 8 + e] * kk[e]; }
                a += bias[j];
                const float mn = fmaxf(mx, a), corr = __expf(mx - mn), pj = __expf(a - mn); mx = mn; l = l * corr + pj;
#pragma unroll
                for (int d = 0; d < 8; ++d) { float vv[8]; ld8(kbase + 512 + (size_t)j * DIN + d * 8, vv);
#pragma unroll
                    for (int e = 0; e < 8; ++e) o[d * 8 + e] = o[d * 8 + e] * corr + pj * vv[e]; } }
        }
        const float inv = 1.0f / l;
#pragma unroll
        for (int d = 0; d < 8; ++d) { u32x4 w; w.x = pk2(o[d * 8] * inv, o[d * 8 + 1] * inv); w.y = pk2(o[d * 8 + 2] * inv, o[d * 8 + 3] * inv); w.z = pk2(o[d * 8 + 4] * inv, o[d * 8 + 5] * inv); w.w = pk2(o[d * 8 + 6] * inv, o[d * 8 + 7] * inv);
            *(u32x4*)(ao + (size_t)t * DATT + h * 64 + d * 8) = w; }
    }
}
__device__ void ph_pool_v0(const bf16* proj, bf16* pooled) {
    for (int idx = blockIdx.x * NT + threadIdx.x; idx < M * (DPOOL / 8); idx += gridDim.x * NT) {
        const int t = idx >> 6, c8 = idx & 63, ch = c8 * 8, g = ch >> 7, half = 1 << g, b = t >> 12, s = t & 4095;
        const int lo = (s - half) < 0 ? 0 : s - half, hi = (s + half) > SEQ ? SEQ : s + half;
        float acc[8] = {0.f, 0.f, 0.f, 0.f, 0.f, 0.f, 0.f, 0.f};
        for (int ss = lo; ss < hi; ++ss) { float v[8]; ld8(proj + ((size_t)(b << 12) + ss) * DIN + 1536 + ch, v);
#pragma unroll
            for (int e = 0; e < 8; ++e) acc[e] += v[e]; }
        float own[8]; ld8(proj + (size_t)t * DIN + 1536 + ch, own); const float inv = 1.0f / (float)(hi - lo);
        u32x4 w; w.x = pk2(acc[0] * inv - own[0], acc[1] * inv - own[1]); w.y = pk2(acc[2] * inv - own[2], acc[3] * inv - own[3]);
        w.z = pk2(acc[4] * inv - own[4], acc[5] * inv - own[5]); w.w = pk2(acc[6] * inv - own[6], acc[7] * inv - own[7]);
        *(u32x4*)(pooled + (size_t)t * DPOOL + ch) = w;
    }
}


#define XB_TMO      128
#define XB_XCNT(j)  (256  + 64 * (j))
#define XB_XSUB(j)  (1280 + 64 * (j))
#define XB_XGEN(j)  (2304 + 64 * (j))
#define XB_TOP      3328
#define XB_TOPGEN   3392
#define XCD_BAR_WORDS 3456
#define XB_SPIN_CAP (1u << 18)
__device__ __forceinline__ unsigned xb_ld(unsigned* p)              { return __hip_atomic_load(p, __ATOMIC_RELAXED, __HIP_MEMORY_SCOPE_AGENT); }
__device__ __forceinline__ unsigned xb_add(unsigned* p, unsigned v) { return __hip_atomic_fetch_add(p, v, __ATOMIC_RELAXED, __HIP_MEMORY_SCOPE_AGENT); }
__device__ __forceinline__ unsigned xb_xcc_id() { return (unsigned)__builtin_amdgcn_s_getreg((3 << 11) | 20) & 0xFu; }
#define XB_SPIN(cond, bar) do { unsigned _sp = 0; while (cond) { __builtin_amdgcn_s_sleep(1); \
    if ((++_sp & 255u) == 0u) { if (xb_ld(&(bar)[XB_TMO])) break; if (_sp > XB_SPIN_CAP) { atomicAdd(&(bar)[XB_TMO], 1u); break; } } } } while (0)
struct XcdBarrier { unsigned* bar; unsigned x; volatile LAS unsigned* st; };
__device__ __forceinline__ XcdBarrier xcd_barrier_post(unsigned* bar, volatile LAS unsigned* st) {
    XcdBarrier b; b.bar = bar; b.x = xb_xcc_id(); b.st = st;
    if (threadIdx.x == 0) (void)xb_add(&bar[XB_XCNT(b.x)], 1u);
    return b;
}
__device__ __forceinline__ void xcd_barrier_complete(unsigned* bar, unsigned x, unsigned& nloc, unsigned& nx) {
    const unsigned G = gridDim.x * gridDim.y * gridDim.z;
    unsigned sum, cnt, mine, sp = 0u;
    for (;;) {
        sum = 0u; cnt = 0u; mine = 0u;
#pragma unroll
        for (unsigned j = 0; j < 16; ++j) { const unsigned c = xb_ld(&bar[XB_XCNT(j)]); sum += c; cnt += (c > 0u) ? 1u : 0u; mine = (j == x) ? c : mine; }
        if (sum == G) break;
        __builtin_amdgcn_s_sleep(1);
        if ((++sp & 255u) == 0u) { if (xb_ld(&bar[XB_TMO])) break; if (sp > XB_SPIN_CAP) { atomicAdd(&bar[XB_TMO], 1u); break; } }
    }
    nloc = mine > 0u ? mine : 1u; nx = cnt > 0u ? cnt : 1u;
}
__device__ __forceinline__ void xcd_barrier(const XcdBarrier& b) {
    asm volatile("s_waitcnt vmcnt(0)" ::: "memory");
    __syncthreads();
    if (threadIdx.x == 0) {
        unsigned* bar = b.bar;
        __builtin_amdgcn_s_waitcnt(0);
        unsigned nloc = b.st[0], nx = b.st[1];
        if (nloc == 0u) { xcd_barrier_complete(bar, b.x, nloc, nx); b.st[0] = nloc; b.st[1] = nx; }
        const unsigned old = xb_add(&bar[XB_XSUB(b.x)], 1u);
        const unsigned gen = old / nloc;
        if (old + 1u == (gen + 1u) * nloc) {
            __builtin_amdgcn_fence(__ATOMIC_RELEASE, "agent");
            asm volatile("s_waitcnt vmcnt(0)" ::: "memory");
            const unsigned og = xb_add(&bar[XB_TOP], 1u);
            const unsigned tg = og / nx;
            if (og + 1u == (tg + 1u) * nx) xb_add(&bar[XB_TOPGEN], 1u);
            else XB_SPIN(xb_ld(&bar[XB_TOPGEN]) == tg, bar);
            __builtin_amdgcn_fence(__ATOMIC_ACQUIRE, "agent");
            xb_add(&bar[XB_XGEN(b.x)], 1u);
            asm volatile("s_waitcnt vmcnt(0)" ::: "memory");
        } else {
            XB_SPIN(xb_ld(&bar[XB_XGEN(b.x)]) == gen, bar);
            __builtin_amdgcn_fence(__ATOMIC_ACQUIRE, "agent");
            asm volatile("s_waitcnt vmcnt(0)" ::: "memory");
        }
    }
    __syncthreads();
}

constexpr int RING_BYTES = 131072, LDSCTL_OFF = RING_BYTES, MISC_OFF = LDSCTL_OFF + 320, LDS_BYTES = 147456;
constexpr int CW_BAR = 4096;
constexpr size_t CTL_ZERO_BYTES = 1 * MiB;

__global__ void __launch_bounds__(NT, 2) fwd_kernel(P p) {
    extern __shared__ __attribute__((aligned(16))) unsigned char lds_raw[];
    LAS unsigned char* lds = (LAS unsigned char*)lds_raw;
    unsigned char* ws = p.ws;
    for (int u = threadIdx.x; u < (LDS_BYTES - LDSCTL_OFF) / 4; u += NT) ((LAS unsigned*)(lds + LDSCTL_OFF))[u] = 0u;
    __syncthreads();
    const XcdBarrier bar = xcd_barrier_post((unsigned*)ws + CW_BAR, (volatile LAS unsigned*)(lds + MISC_OFF) + 8);
#define GRID_BAR() xcd_barrier(bar)
    bf16* U = (bf16*)(ws + WS_U);
    ph_prologue(p, lds); ph_norm_in(p.x, U);
    GRID_BAR();
    { Gemm g{U, (const bf16*)(ws + WS_W1GU), M, NGU, DM}; EpiSwiglu E{(bf16*)(ws + WS_R1)}; gemm_simple(lds, g, E); }
    GRID_BAR();
    { Gemm g{(const bf16*)(ws + WS_R1), (const bf16*)(ws + WS_W1D), M, DM, DFF}; EpiStoreF32 E{(float*)(ws + WS_R2), DM}; gemm_simple(lds, g, E); }
    GRID_BAR();
    ph_norm_res((const float*)(ws + WS_R2), p.x, p.g1post, 0.5f, p.out, U);
    GRID_BAR();
    { Gemm g{U, (const bf16*)(ws + WS_WIN), M, DIN, DM}; EpiStoreBf16 E{(bf16*)(ws + WS_R1), DIN}; gemm_simple(lds, g, E); }
    GRID_BAR();
    ph_attn_v0((const bf16*)(ws + WS_R1), p.rpb, (bf16*)(ws + WS_ATT)); ph_pool_v0((const bf16*)(ws + WS_R1), (bf16*)(ws + WS_POOLED));
    GRID_BAR();
    { Gemm g{(const bf16*)(ws + WS_ATT), (const bf16*)(ws + WS_WBA), M, DM, DATT}; EpiGateMul E{(const bf16*)(ws + WS_R1) + 2048, DIN, (bf16*)(ws + WS_R2)}; gemm_simple(lds, g, E); }
    GRID_BAR();
    { Gemm g{(const bf16*)(ws + WS_POOLED), (const bf16*)(ws + WS_WCOMB), M, DM, DPOOL}; EpiGateAdd E{(const bf16*)(ws + WS_R1) + 3072, DIN, (const bf16*)(ws + WS_R2), (bf16*)(ws + WS_MERGED)}; gemm_simple(lds, g, E); }
    GRID_BAR();
    { Gemm g{(const bf16*)(ws + WS_MERGED), (const bf16*)(ws + WS_WOUT), M, DM, DM}; EpiStoreF32 E{(float*)(ws + WS_R1), DM}; gemm_simple(lds, g, E); }
    GRID_BAR();
    ph_norm_res((const float*)(ws + WS_R1), p.out, p.gmpost, 1.0f, p.out, U);
    GRID_BAR();
    { Gemm g{U, (const bf16*)(ws + WS_W2GU), M, NGU, DM}; EpiSwiglu E{(bf16*)(ws + WS_R1)}; gemm_simple(lds, g, E); }
    GRID_BAR();
    { Gemm g{(const bf16*)(ws + WS_R1), (const bf16*)(ws + WS_W2D), M, DM, DFF}; EpiStoreF32 E{(float*)(ws + WS_R2), DM}; gemm_simple(lds, g, E); }
    GRID_BAR();
    ph_norm_res((const float*)(ws + WS_R2), p.out, p.g2post, 0.5f, p.out, U); ph_cvt_p(p.p, (bf16*)(ws + WS_R1));
    GRID_BAR();
    { Gemm g{(const bf16*)(ws + WS_R1), (const bf16*)(ws + WS_WPP), M, DM, PLE}; EpiStoreF32 E{(float*)(ws + WS_T2), DM}; gemm_simple(lds, g, E); }
    GRID_BAR();
    { Gemm g{U, (const bf16*)(ws + WS_WPG), M, DM, DM}; EpiPle E{(const float*)(ws + WS_T2), (float*)(ws + WS_R2)}; gemm_simple(lds, g, E); }
    GRID_BAR();
    ph_norm_res((const float*)(ws + WS_R2), p.out, p.gppost, 1.0f, p.out, nullptr);
}

extern "C" void kernel_launch(void* const* d_in, const int* in_sizes, int n_in, void* d_out, int out_size, void* d_ws, size_t ws_size, hipStream_t stream) {
    static int grid = 0;
    if (grid == 0) {
        if (n_in != 25 || out_size != M * DM || ws_size < 512 * MiB) { fprintf(stderr, "kernel_launch: unexpected shapes n_in %d out %d ws %zu\n", n_in, out_size, ws_size); grid = -1; return; }
        int dev = 0, cus = 0, per_cu = 0;
        if (hipGetDevice(&dev) != hipSuccess || hipDeviceGetAttribute(&cus, hipDeviceAttributeMultiprocessorCount, dev) != hipSuccess) { grid = -1; return; }
        if (hipFuncSetAttribute((const void*)fwd_kernel, hipFuncAttributeMaxDynamicSharedMemorySize, LDS_BYTES) != hipSuccess) { fprintf(stderr, "kernel_launch: hipFuncSetAttribute failed\n"); grid = -1; return; }
        if (hipOccupancyMaxActiveBlocksPerMultiprocessor(&per_cu, (const void*)fwd_kernel, NT, LDS_BYTES) != hipSuccess || per_cu < 1) { fprintf(stderr, "kernel_launch: occupancy query says %d\n", per_cu); per_cu = 1; }
        (void)hipGetLastError();
        grid = cus;
    }
    if (grid < 0) return;
    if (hipMemsetAsync(d_ws, 0, CTL_ZERO_BYTES, stream) != hipSuccess) return;
    P p{};
    const float** f = (const float**)&p;
    for (int i = 0; i < 25; ++i) f[i] = (const float*)d_in[i];
    p.out = (float*)d_out; p.ws = (unsigned char*)d_ws;
    hipLaunchKernelGGL(fwd_kernel, dim3(grid), dim3(NT), LDS_BYTES, stream, p);
}
```

```cpp
#include <hip/hip_runtime.h>
#include <cstdint>
#include <cstdio>

#define LAS __attribute__((address_space(3)))
typedef unsigned short bf16;
typedef short bf16x8 __attribute__((ext_vector_type(8)));
typedef float f32x4 __attribute__((ext_vector_type(4)));
typedef unsigned u32x4 __attribute__((ext_vector_type(4)));
typedef unsigned u32x2 __attribute__((ext_vector_type(2)));

constexpr int BATCH = 8, SEQ = 4096, DM = 1024, M = BATCH * SEQ, DFF = 2816, NGU = 2 * DFF, DIN = 4096;
constexpr int DATT = 512, DPOOL = 512, PLE = 256, NH = 8, HD = 64;
constexpr float EPS = 1e-6f;
constexpr int NT = 512, NWAVES = 8;

constexpr size_t MiB = 1u << 20;
constexpr size_t WS_W1GU = 1 * MiB, WS_W1D = 12 * MiB, WS_WIN = 18 * MiB, WS_WBA = 26 * MiB, WS_WCOMB = 27 * MiB, WS_WOUT = 28 * MiB;
constexpr size_t WS_W2GU = 30 * MiB, WS_W2D = 41 * MiB, WS_WPG = 47 * MiB, WS_WPP = 49 * MiB;
constexpr size_t WS_U = 64 * MiB;
constexpr size_t WS_ATT = 64 * MiB, WS_POOLED = 96 * MiB;
constexpr size_t WS_R1 = 128 * MiB;
constexpr size_t WS_T2 = 256 * MiB;
constexpr size_t WS_R2 = 384 * MiB;
constexpr size_t WS_MERGED = 448 * MiB;

struct P {
    const float *x, *p, *g1pre, *g1post, *w1g, *w1u, *w1d, *gmpre, *gmpost, *win, *rpb, *poolw, *pools, *wba, *wbp, *wout;
    const float *g2pre, *g2post, *w2g, *w2u, *w2d, *gppre, *gppost, *wpp, *wpg;
    float* out; unsigned char* ws;
};

__device__ __forceinline__ unsigned f2bf(float f) { unsigned u = __builtin_bit_cast(unsigned, f); return (u + 0x7fffu + ((u >> 16) & 1u)) >> 16; }
__device__ __forceinline__ unsigned pk2(float lo, float hi) { return f2bf(lo) | (f2bf(hi) << 16); }
__device__ __forceinline__ float bf2f(unsigned b) { return __builtin_bit_cast(float, b << 16); }
__device__ __forceinline__ float bflo(unsigned w) { return __builtin_bit_cast(float, w << 16); }
__device__ __forceinline__ float bfhi(unsigned w) { return __builtin_bit_cast(float, w & 0xffff0000u); }
__device__ __forceinline__ float sigmoidf_(float v) { return 1.0f / (1.0f + __expf(-v)); }
__device__ __forceinline__ float wave_sum(float v) {
#pragma unroll
    for (int o = 1; o < 64; o <<= 1) v += __shfl_xor(v, o);
    return v;
}

__device__ __forceinline__ void transpose_item(const float* src_lane, int ldsrc, const float* gk, int K, bf16* dst_n0, int k0, LAS float* scr, int lane) {
#pragma unroll 8
    for (int i = 0; i < 32; ++i) { const int kk = 2 * i + (lane >> 5); float v = src_lane[(size_t)(k0 + kk) * ldsrc]; if (gk) v *= gk[k0 + kk]; scr[kk * 33 + (lane & 31)] = v; }
    __builtin_amdgcn_s_waitcnt(0xC07F); asm volatile("" ::: "memory");
    const int c = lane & 7;
#pragma unroll
    for (int j = 0; j < 4; ++j) { const int n = (lane >> 3) + 8 * j; const LAS float* s = scr + (8 * c) * 33 + n;
        u32x4 o; o.x = pk2(s[0 * 33], s[1 * 33]); o.y = pk2(s[2 * 33], s[3 * 33]); o.z = pk2(s[4 * 33], s[5 * 33]); o.w = pk2(s[6 * 33], s[7 * 33]);
        *(u32x4*)(dst_n0 + (size_t)n * K + k0 + 8 * c) = o; }
    __builtin_amdgcn_s_waitcnt(0xC07F); asm volatile("" ::: "memory");
}
__device__ __forceinline__ void transpose_plain(const float* W, int K, int N, const float* gk, bf16* dst, LAS float* scr, int gw, int ngw, int lane) {
    const int nblk = N / 32, nitems = (K / 64) * nblk;
    for (int it = gw; it < nitems; it += ngw) { const int kb = it / nblk, nb = it % nblk;
        transpose_item(W + nb * 32 + (lane & 31), N, gk, K, dst + (size_t)(nb * 32) * K, kb * 64, scr, lane); }
}
__device__ __forceinline__ void transpose_gu(const float* Wg, const float* Wu, const float* gk, bf16* dst, LAS float* scr, int gw, int ngw, int lane) {
    const int nblk = NGU / 32, nitems = (DM / 64) * nblk;
    for (int it = gw; it < nitems; it += ngw) { const int kb = it / nblk, nb = it % nblk; const int w = lane & 31;
        const float* src = (w < 16 ? Wg : Wu) + nb * 16 + (w & 15);
        transpose_item(src, DFF, gk, DM, dst + (size_t)(nb * 32) * DM, kb * 64, scr, lane); }
}
__device__ void ph_prologue(const P& p, LAS unsigned char* lds) {
    const int tid = threadIdx.x, lane = tid & 63, wave = tid >> 6;
    LAS float* scr = (LAS float*)(lds + wave * 16384);
    const int gw = blockIdx.x * NWAVES + wave, ngw = gridDim.x * NWAVES;
    unsigned char* ws = p.ws;
    transpose_gu(p.w1g, p.w1u, p.g1pre, (bf16*)(ws + WS_W1GU), scr, gw, ngw, lane);
    transpose_plain(p.w1d, DFF, DM, nullptr, (bf16*)(ws + WS_W1D), scr, gw, ngw, lane);
    transpose_plain(p.win, DM, DIN, p.gmpre, (bf16*)(ws + WS_WIN), scr, gw, ngw, lane);
    transpose_plain(p.wba, DATT, DM, nullptr, (bf16*)(ws + WS_WBA), scr, gw, ngw, lane);
    transpose_plain(p.wout, DM, DM, nullptr, (bf16*)(ws + WS_WOUT), scr, gw, ngw, lane);
    transpose_gu(p.w2g, p.w2u, p.g2pre, (bf16*)(ws + WS_W2GU), scr, gw, ngw, lane);
    transpose_plain(p.w2d, DFF, DM, nullptr, (bf16*)(ws + WS_W2D), scr, gw, ngw, lane);
    transpose_plain(p.wpg, DM, DM, p.gppre, (bf16*)(ws + WS_WPG), scr, gw, ngw, lane);
    transpose_plain(p.wpp, PLE, DM, nullptr, (bf16*)(ws + WS_WPP), scr, gw, ngw, lane);
    bf16* wc = (bf16*)(ws + WS_WCOMB);
    for (int idx = blockIdx.x * NT + tid; idx < DPOOL * DM; idx += gridDim.x * NT) {
        const int n = idx & (DM - 1), k = idx >> 10, g = k >> 7, kl = k & 127;
        const float* pw = p.poolw + ((size_t)g * 128 + kl) * 128; const float* ps = p.pools + g * 128; const float* wb = p.wbp + (size_t)(g * 128) * DM + n;
        float s = 0.f;
        for (int j = 0; j < 128; ++j) s += pw[j] * ps[j] * wb[(size_t)j * DM];
        wc[(size_t)n * DPOOL + k] = (bf16)f2bf(s);
    }
}

__device__ __forceinline__ void row_load(const float* row, int lane, f32x4 (&v)[4]) {
#pragma unroll
    for (int j = 0; j < 4; ++j) v[j] = *((const f32x4*)row + lane + 64 * j);
}
__device__ __forceinline__ float row_ss(const f32x4 (&v)[4]) {
    float s = 0.f;
#pragma unroll
    for (int j = 0; j < 4; ++j) s += (v[j].x * v[j].x + v[j].y * v[j].y) + (v[j].z * v[j].z + v[j].w * v[j].w);
    return wave_sum(s);
}
__device__ __forceinline__ void row_store_bf16(bf16* row, int lane, const f32x4 (&v)[4], float sc) {
#pragma unroll
    for (int j = 0; j < 4; ++j) { u32x2 w; w.x = pk2(v[j].x * sc, v[j].y * sc); w.y = pk2(v[j].z * sc, v[j].w * sc); *((u32x2*)row + lane + 64 * j) = w; }
}
__device__ void ph_norm_in(const float* x, bf16* u) {
    const int lane = threadIdx.x & 63, gw = blockIdx.x * NWAVES + (threadIdx.x >> 6), ngw = gridDim.x * NWAVES;
    for (int r = gw; r < M; r += ngw) { f32x4 v[4]; row_load(x + (size_t)r * DM, lane, v);
        const float rs = rsqrtf(row_ss(v) * (1.0f / DM) + EPS); row_store_bf16(u + (size_t)r * DM, lane, v, rs); }
}
__device__ void ph_norm_res(const float* f, const float* hin, const float* g, float scale, float* hout, bf16* u) {
    const int lane = threadIdx.x & 63, gw = blockIdx.x * NWAVES + (threadIdx.x >> 6), ngw = gridDim.x * NWAVES;
    f32x4 gv[4]; row_load(g, lane, gv);
    for (int r = gw; r < M; r += ngw) { f32x4 v[4], h[4]; row_load(f + (size_t)r * DM, lane, v); row_load(hin + (size_t)r * DM, lane, h);
        const float rs = rsqrtf(row_ss(v) * (1.0f / DM) + EPS) * scale;
#pragma unroll
        for (int j = 0; j < 4; ++j) { h[j] = h[j] + v[j] * gv[j] * rs; *((f32x4*)(hout + (size_t)r * DM) + lane + 64 * j) = h[j]; }
        if (u) { const float r2 = rsqrtf(row_ss(h) * (1.0f / DM) + EPS); row_store_bf16(u + (size_t)r * DM, lane, h, r2); }
    }
}
__device__ void ph_cvt_p(const float* p, bf16* o) {
    for (size_t i = (size_t)blockIdx.x * NT + threadIdx.x; i < (size_t)M * PLE / 4; i += (size_t)gridDim.x * NT) {
        const f32x4 v = *((const f32x4*)p + i); u32x2 w; w.x = pk2(v.x, v.y); w.y = pk2(v.z, v.w); *((u32x2*)o + i) = w; }
}

namespace pg8 {
#define PG8_LAS __attribute__((address_space(3)))
typedef unsigned short bf16_t;
typedef short bf16x8 __attribute__((ext_vector_type(8)));
typedef float f32x4 __attribute__((ext_vector_type(4)));
typedef unsigned u32x4 __attribute__((ext_vector_type(4)));
constexpr int BM = 256, BK = 64, HALF = 128, HTB = HALF * BK * 2  , STAGE_BYTES = 8 * HTB, NXCD = 8, WGM = 8;

__host__ __device__ __forceinline__ int lds_byte(int r, int c) { const int st = (r >> 4) * 2 + (c >> 5), rr = r & 15, cc = c & 31, ob = rr * 64 + cc * 2; return st * 1024 + (ob ^ (((ob >> 9) & 1) << 5)); }
__host__ __device__ __forceinline__ void stage_rc(int b, int& R, int& C) { const int st = b / 1024, sb = b % 1024, swz = sb ^ (((sb >> 9) & 1) << 5); R = (st >> 1) * 16 + swz / 64; C = (st & 1) * 32 + (swz % 64) / 2; }
__host__ __device__ __forceinline__ int perm32(int rho) { const int n = rho >> 4, i = rho & 15; return 8 * (i >> 2) + 4 * n + (i & 3); }

struct Unit { int pm, pn; };
struct Gemm { const bf16_t* A; const bf16_t* Bt; int M, N, K; };

struct StaticOrder {
    int nM, nN, nwg, G, c;
    __host__ __device__ void init(int M, int N, int G_, int c_) { nM = M / BM; nN = N / BM; nwg = nM * nN; G = G_; c = c_; }
    __host__ __device__ bool next(int i, Unit& u) const {
        const long L = (long)i * G + c; if (L >= nwg) return false;
        int wgid = (int)L; { const int q = nwg / NXCD, r = nwg % NXCD, xcd = wgid % NXCD, off = wgid / NXCD; wgid = (xcd < r ? xcd * (q + 1) : r * (q + 1) + (xcd - r) * q) + off; }
        const int nig = WGM * nN, gid = wgid / nig, fm = gid * WGM, gsz = (nM - fm) < WGM ? (nM - fm) : WGM;
        u.pm = fm + ((wgid % nig) % gsz); u.pn = (wgid % nig) / gsz; return true;
    }
    __device__ __forceinline__ void a_ready(const Unit&) const {}
    __device__ __forceinline__ void done(const Unit&) const {}
};

}
using pg8::Unit; using pg8::Gemm;

template <class Epi>
__device__ __forceinline__ void gemm_simple(LAS unsigned char* lds, const Gemm g, const Epi& E) {
    const int tid = threadIdx.x, wid = tid >> 6, lane = tid & 63, wr = wid >> 2, wc = wid & 3, fr = lane & 15, fq = lane >> 4;
    constexpr int RS = 144;
    LAS unsigned char* sA = lds; LAS unsigned char* sB = lds + 256 * RS;
    const int nN = g.N / 256, nU = (g.M / 256) * nN;
    for (int unit = blockIdx.x; unit < nU; unit += gridDim.x) {
        Unit u; u.pm = unit / nN; u.pn = unit % nN;
        f32x4 acc[2][2][4][2];
#pragma unroll
        for (int a = 0; a < 2; ++a)
#pragma unroll
            for (int b = 0; b < 2; ++b)
#pragma unroll
                for (int m = 0; m < 4; ++m)
#pragma unroll
                    for (int n = 0; n < 2; ++n) acc[a][b][m][n] = (f32x4){0.f, 0.f, 0.f, 0.f};
        const bf16* Ab = g.A + (size_t)u.pm * 256 * g.K; const bf16* Bb = g.Bt + (size_t)u.pn * 256 * g.K;
        for (int k0 = 0; k0 < g.K; k0 += 64) {
#pragma unroll
            for (int i = 0; i < 4; ++i) { const int ch = tid + NT * i, row = ch >> 3, cc = ch & 7;
                const u32x4 va = *(const u32x4*)(Ab + (size_t)row * g.K + k0 + cc * 8); const u32x4 vb = *(const u32x4*)(Bb + (size_t)row * g.K + k0 + cc * 8);
                *(LAS u32x4*)(sA + row * RS + cc * 16) = va; *(LAS u32x4*)(sB + row * RS + cc * 16) = vb; }
            __syncthreads();
#pragma unroll
            for (int ks = 0; ks < 2; ++ks) {
                bf16x8 At[2][4], Bf[2][2];
#pragma unroll
                for (int ai = 0; ai < 2; ++ai)
#pragma unroll
                    for (int m = 0; m < 4; ++m) At[ai][m] = *(const LAS bf16x8*)(sA + (128 * ai + 64 * wr + 16 * m + fr) * RS + ks * 64 + fq * 16);
#pragma unroll
                for (int bj = 0; bj < 2; ++bj)
#pragma unroll
                    for (int n = 0; n < 2; ++n) Bf[bj][n] = *(const LAS bf16x8*)(sB + (128 * bj + 32 * wc + 16 * n + fr) * RS + ks * 64 + fq * 16);
#pragma unroll
                for (int ai = 0; ai < 2; ++ai)
#pragma unroll
                    for (int bj = 0; bj < 2; ++bj)
#pragma unroll
                        for (int m = 0; m < 4; ++m)
#pragma unroll
                            for (int n = 0; n < 2; ++n) acc[ai][bj][m][n] = __builtin_amdgcn_mfma_f32_16x16x32_bf16(Bf[bj][n], At[ai][m], acc[ai][bj][m][n], 0, 0, 0);
            }
            __syncthreads();
        }
        E(acc, u, wr, wc, fr, fq);
    }
}

#define EPI_LOOP_BEGIN \
    _Pragma("unroll") for (int ai = 0; ai < 2; ++ai) _Pragma("unroll") for (int m = 0; m < 4; ++m) { const int row = u.pm * 256 + ai * 128 + wr * 64 + m * 16 + fr; \
    _Pragma("unroll") for (int bj = 0; bj < 2; ++bj)
struct EpiSwiglu {
    static constexpr bool PERM = false, AFTER_DRAIN = false;
    bf16* O;
    __device__ __forceinline__ void operator()(const f32x4 (&acc)[2][2][4][2], const Unit& u, int wr, int wc, int fr, int fq) const {
        EPI_LOOP_BEGIN { const int col = u.pn * 128 + bj * 64 + wc * 16 + 4 * fq; const f32x4 G = acc[ai][bj][m][0], U = acc[ai][bj][m][1]; float o[4];
#pragma unroll
            for (int i = 0; i < 4; ++i) o[i] = G[i] * sigmoidf_(G[i]) * U[i];
            u32x2 w; w.x = pk2(o[0], o[1]); w.y = pk2(o[2], o[3]); *(u32x2*)(O + (size_t)row * DFF + col) = w; } }
    }
};
struct EpiStoreF32 {
    static constexpr bool PERM = false, AFTER_DRAIN = false;
    float* C; int ldc;
    __device__ __forceinline__ void operator()(const f32x4 (&acc)[2][2][4][2], const Unit& u, int wr, int wc, int fr, int fq) const {
        EPI_LOOP_BEGIN {
#pragma unroll
            for (int n = 0; n < 2; ++n) { const int col = u.pn * 256 + bj * 128 + wc * 32 + n * 16 + 4 * fq; *(f32x4*)(C + (size_t)row * ldc + col) = acc[ai][bj][m][n]; } } }
    }
};
struct EpiStoreBf16 {
    static constexpr bool PERM = false, AFTER_DRAIN = false;
    bf16* C; int ldc;
    __device__ __forceinline__ void operator()(const f32x4 (&acc)[2][2][4][2], const Unit& u, int wr, int wc, int fr, int fq) const {
        EPI_LOOP_BEGIN {
#pragma unroll
            for (int n = 0; n < 2; ++n) { const int col = u.pn * 256 + bj * 128 + wc * 32 + n * 16 + 4 * fq; const f32x4 v = acc[ai][bj][m][n];
                u32x2 w; w.x = pk2(v[0], v[1]); w.y = pk2(v[2], v[3]); *(u32x2*)(C + (size_t)row * ldc + col) = w; } } }
    }
};
struct EpiGateMul {
    static constexpr bool PERM = false, AFTER_DRAIN = false;
    const bf16* gate; int ldg; bf16* T;
    __device__ __forceinline__ void operator()(const f32x4 (&acc)[2][2][4][2], const Unit& u, int wr, int wc, int fr, int fq) const {
        EPI_LOOP_BEGIN {
#pragma unroll
            for (int n = 0; n < 2; ++n) { const int col = u.pn * 256 + bj * 128 + wc * 32 + n * 16 + 4 * fq; const f32x4 v = acc[ai][bj][m][n];
                const u32x2 gw = *(const u32x2*)(gate + (size_t)row * ldg + col);
                const float o0 = sigmoidf_(bflo(gw.x)) * v[0], o1 = sigmoidf_(bfhi(gw.x)) * v[1], o2 = sigmoidf_(bflo(gw.y)) * v[2], o3 = sigmoidf_(bfhi(gw.y)) * v[3];
                u32x2 w; w.x = pk2(o0, o1); w.y = pk2(o2, o3); *(u32x2*)(T + (size_t)row * DM + col) = w; } } }
    }
};
struct EpiGateAdd {
    static constexpr bool PERM = false, AFTER_DRAIN = false;
    const bf16* gate; int ldg; const bf16* T; bf16* Mg;
    __device__ __forceinline__ void operator()(const f32x4 (&acc)[2][2][4][2], const Unit& u, int wr, int wc, int fr, int fq) const {
        EPI_LOOP_BEGIN {
#pragma unroll
            for (int n = 0; n < 2; ++n) { const int col = u.pn * 256 + bj * 128 + wc * 32 + n * 16 + 4 * fq; const f32x4 v = acc[ai][bj][m][n];
                const u32x2 gw = *(const u32x2*)(gate + (size_t)row * ldg + col); const u32x2 tw = *(const u32x2*)(T + (size_t)row * DM + col);
                const float o0 = bflo(tw.x) + sigmoidf_(bflo(gw.x)) * v[0], o1 = bfhi(tw.x) + sigmoidf_(bfhi(gw.x)) * v[1], o2 = bflo(tw.y) + sigmoidf_(bflo(gw.y)) * v[2], o3 = bfhi(tw.y) + sigmoidf_(bfhi(gw.y)) * v[3];
                u32x2 w; w.x = pk2(o0, o1); w.y = pk2(o2, o3); *(u32x2*)(Mg + (size_t)row * DM + col) = w; } } }
    }
};
struct EpiPle {
    static constexpr bool PERM = false, AFTER_DRAIN = false;
    const float* T2; float* E;
    __device__ __forceinline__ void operator()(const f32x4 (&acc)[2][2][4][2], const Unit& u, int wr, int wc, int fr, int fq) const {
        EPI_LOOP_BEGIN {
#pragma unroll
            for (int n = 0; n < 2; ++n) { const int col = u.pn * 256 + bj * 128 + wc * 32 + n * 16 + 4 * fq; const f32x4 v = acc[ai][bj][m][n];
                const f32x4 t = *(const f32x4*)(T2 + (size_t)row * DM + col); f32x4 o;
#pragma unroll
                for (int i = 0; i < 4; ++i) o[i] = t[i] * sigmoidf_(v[i]);
                *(f32x4*)(E + (size_t)row * DM + col) = o; } } }
    }
};

namespace pg8 {
template <class Epi, class Sched, bool ALIGN_EPI = false, bool SP2 = false>
__device__ __forceinline__ void gemm_phase(PG8_LAS unsigned char* lds, const Gemm g, const Sched& S, const Epi& E) {
    const int tid = threadIdx.x, wid = __builtin_amdgcn_readfirstlane(tid >> 6), lane = tid & 63, wr = wid >> 2, wc = wid & 3, fr = lane & 15, fq = lane >> 4;
    const int K = g.K, nt = K / BK;
    unsigned voffA[2], voffB[2];
#pragma unroll
    for (int i = 0; i < 2; ++i) { int R, C; stage_rc(tid * 16 + i * 8192, R, C); const int Rb = Epi::PERM ? ((R & ~31) + perm32(R & 31)) : R;
        voffA[i] = (unsigned)(R * K + C) * 2u; voffB[i] = (unsigned)(Rb * K + C) * 2u; }
    const size_t kstep = (size_t)(BK * 2);
    const size_t hstep = (size_t)HALF * K * 2;
    const size_t tstep = 2 * hstep;
    const unsigned ldsw = (unsigned)wid * 1024u;
    const int aoff = lds_byte(wr * 64 + fr, fq * 8), boff = lds_byte(wc * 32 + fr, fq * 8);
#define PG8_SA(b, h) (((b) * 2 + (h)) * HTB)
#define PG8_SB(b, h) ((4 + (b) * 2 + (h)) * HTB)
#define PG8_STAGE(bufoff, gbase, voff) do { _Pragma("unroll") for (int _i = 0; _i < 2; ++_i) \
        __builtin_amdgcn_global_load_lds((const unsigned*)((const char*)(gbase) + (voff)[_i]), (PG8_LAS unsigned*)(lds + (bufoff) + ldsw + _i * 8192), 16, 0, 0); } while (0)
#define PG8_LDA(dst, b, h) do { _Pragma("unroll") for (int m = 0; m < 4; ++m) _Pragma("unroll") for (int k = 0; k < 2; ++k) dst[m][k] = *(const PG8_LAS bf16x8*)(lds + PG8_SA(b, h) + aoff + m * 2048 + k * 1024); } while (0)
#define PG8_LDB(dst, b, h) do { _Pragma("unroll") for (int n = 0; n < 2; ++n) _Pragma("unroll") for (int k = 0; k < 2; ++k) dst[n][k] = *(const PG8_LAS bf16x8*)(lds + PG8_SB(b, h) + boff + n * 2048 + k * 1024); } while (0)
#define PG8_MMA(ai, bj, At, Bt) do { __builtin_amdgcn_s_setprio(1); _Pragma("unroll") for (int m = 0; m < 4; ++m) _Pragma("unroll") for (int n = 0; n < 2; ++n) _Pragma("unroll") for (int k = 0; k < 2; ++k) \
        acc[ai][bj][m][n] = __builtin_amdgcn_mfma_f32_16x16x32_bf16(Bt[n][k], At[m][k], acc[ai][bj][m][n], 0, 0, 0); __builtin_amdgcn_s_setprio(0); } while (0)
#define PG8_WAIT_V(n) asm volatile("s_waitcnt vmcnt(" #n ")" ::: "memory")
#define PG8_WAIT_L(n) asm volatile("s_waitcnt lgkmcnt(" #n ")" ::: "memory")
#define PG8_BAR __builtin_amdgcn_s_barrier()
#define PG8_SCHED __builtin_amdgcn_sched_barrier(0)
    Unit cur, nxt; int ui = 0;
    if (!S.next(0, cur)) return;
    f32x4 acc[2][2][4][2];
#pragma unroll
    for (int a = 0; a < 2; ++a)
#pragma unroll
        for (int b = 0; b < 2; ++b)
#pragma unroll
            for (int m = 0; m < 4; ++m)
#pragma unroll
                for (int n = 0; n < 2; ++n) acc[a][b][m][n] = (f32x4){0.f, 0.f, 0.f, 0.f};
    bf16x8 At[4][2], B0[2][2], B1[2][2];
    const char* cA = (const char*)g.A + (size_t)cur.pm * tstep; const char* cB = (const char*)g.Bt + (size_t)cur.pn * tstep;
    S.a_ready(cur);
    if constexpr (SP2) {
        PG8_STAGE(PG8_SB(0, 0), cB, voffB); PG8_STAGE(PG8_SB(0, 1), cB + hstep, voffB); PG8_STAGE(PG8_SA(0, 0), cA, voffA); PG8_STAGE(PG8_SA(0, 1), cA + hstep, voffA);
        if (wr == 1) PG8_BAR;
        PG8_WAIT_V(2); PG8_BAR;
        PG8_STAGE(PG8_SB(1, 0), cB + kstep, voffB); PG8_STAGE(PG8_SA(1, 0), cA + kstep, voffA); PG8_STAGE(PG8_SB(1, 1), cB + hstep + kstep, voffB);
        PG8_WAIT_V(6); PG8_BAR;
    } else {
        PG8_STAGE(PG8_SB(0, 0), cB, voffB); PG8_STAGE(PG8_SA(0, 0), cA, voffA); PG8_STAGE(PG8_SB(0, 1), cB + hstep, voffB); PG8_STAGE(PG8_SA(0, 1), cA + hstep, voffA);
        if (wr == 1) PG8_BAR;
        PG8_WAIT_V(4); PG8_BAR;
        PG8_STAGE(PG8_SB(1, 0), cB + kstep, voffB); PG8_STAGE(PG8_SA(1, 0), cA + kstep, voffA); PG8_STAGE(PG8_SB(1, 1), cB + hstep + kstep, voffB);
        PG8_WAIT_V(6); PG8_BAR;
    }
    for (;;) {
        const bool has_next = S.next(ui + 1, nxt);
        const char* nA = has_next ? (const char*)g.A + (size_t)nxt.pm * tstep : cA; const char* nB = has_next ? (const char*)g.Bt + (size_t)nxt.pn * tstep : cB;
        for (int t = 0; t < nt; t += 2) {
            const bool last = (t == nt - 2);
            const char* a1 = cA + (size_t)(t + 1) * kstep;
            const char* a2 = last ? nA : cA + (size_t)(t + 2) * kstep; const char* b2 = last ? nB : cB + (size_t)(t + 2) * kstep;
            const char* a3 = a2 + kstep; const char* b3 = b2 + kstep;
            if (last && has_next) S.a_ready(nxt);
            if constexpr (SP2) {
            PG8_LDB(B0, 0, 0); PG8_LDB(B1, 0, 1); PG8_SCHED; PG8_LDA(At, 0, 0); PG8_STAGE(PG8_SA(1, 1), a1 + hstep, voffA);
            PG8_WAIT_V(8); PG8_WAIT_L(0); PG8_BAR; PG8_MMA(0, 0, At, B0); PG8_MMA(0, 1, At, B1); PG8_BAR; PG8_SCHED;
            PG8_LDA(At, 0, 1); PG8_STAGE(PG8_SB(0, 0), b2, voffB); PG8_STAGE(PG8_SB(0, 1), b2 + hstep, voffB); PG8_STAGE(PG8_SA(0, 0), a2, voffA);
            PG8_WAIT_V(8); PG8_WAIT_L(0); PG8_BAR; PG8_MMA(1, 0, At, B0); PG8_MMA(1, 1, At, B1); PG8_BAR; PG8_SCHED;
            PG8_LDB(B0, 1, 0); PG8_LDB(B1, 1, 1); PG8_SCHED; PG8_LDA(At, 1, 0); PG8_STAGE(PG8_SA(0, 1), a2 + hstep, voffA);
            PG8_WAIT_V(8); PG8_WAIT_L(0); PG8_BAR; PG8_MMA(0, 0, At, B0); PG8_MMA(0, 1, At, B1); PG8_BAR; PG8_SCHED;
            PG8_LDA(At, 1, 1); PG8_STAGE(PG8_SB(1, 0), b3, voffB); PG8_STAGE(PG8_SB(1, 1), b3 + hstep, voffB); PG8_STAGE(PG8_SA(1, 0), a3, voffA);
            PG8_WAIT_V(8); PG8_WAIT_L(0); PG8_BAR; PG8_MMA(1, 0, At, B0); PG8_MMA(1, 1, At, B1); PG8_BAR; PG8_SCHED;
            } else {
            PG8_LDB(B0, 0, 0); PG8_SCHED; PG8_LDA(At, 0, 0); PG8_STAGE(PG8_SA(1, 1), a1 + hstep, voffA);
            PG8_WAIT_L(8); PG8_BAR; PG8_WAIT_L(0); PG8_MMA(0, 0, At, B0); PG8_BAR; PG8_SCHED;
            PG8_LDB(B1, 0, 1); PG8_STAGE(PG8_SB(0, 0), b2, voffB);
            PG8_BAR; PG8_WAIT_L(0); PG8_MMA(0, 1, At, B1); PG8_BAR;
            PG8_LDA(At, 0, 1); PG8_STAGE(PG8_SA(0, 0), a2, voffA);
            PG8_BAR; PG8_WAIT_L(0); PG8_MMA(1, 0, At, B0); PG8_BAR; PG8_SCHED;
            PG8_STAGE(PG8_SB(0, 1), b2 + hstep, voffB);
            PG8_WAIT_V(6); PG8_BAR; PG8_MMA(1, 1, At, B1); PG8_BAR;
            PG8_LDB(B0, 1, 0); PG8_SCHED; PG8_LDA(At, 1, 0); PG8_STAGE(PG8_SA(0, 1), a2 + hstep, voffA);
            PG8_WAIT_L(8); PG8_BAR; PG8_WAIT_L(0); PG8_MMA(0, 0, At, B0); PG8_BAR; PG8_SCHED;
            PG8_LDB(B1, 1, 1); PG8_STAGE(PG8_SB(1, 0), b3, voffB);
            PG8_BAR; PG8_WAIT_L(0); PG8_MMA(0, 1, At, B1); PG8_BAR;
            PG8_LDA(At, 1, 1); PG8_STAGE(PG8_SA(1, 0), a3, voffA);
            PG8_BAR; PG8_WAIT_L(0); PG8_MMA(1, 0, At, B0); PG8_BAR; PG8_SCHED;
            PG8_STAGE(PG8_SB(1, 1), b3 + hstep, voffB);
            PG8_WAIT_V(6); PG8_BAR; PG8_MMA(1, 1, At, B1); PG8_BAR;
            }
        }
        if constexpr (ALIGN_EPI) { if (wr == 0) PG8_BAR; }
        if constexpr (!Epi::AFTER_DRAIN) { E(acc, cur, wr, wc, fr, fq); S.done(cur); }
        if (!has_next) break;
#pragma unroll
        for (int a = 0; a < 2; ++a)
#pragma unroll
            for (int b = 0; b < 2; ++b)
#pragma unroll
                for (int m = 0; m < 4; ++m)
#pragma unroll
                    for (int n = 0; n < 2; ++n) acc[a][b][m][n] = (f32x4){0.f, 0.f, 0.f, 0.f};
        cur = nxt; cA = nA; cB = nB; ++ui;
        if constexpr (ALIGN_EPI) { if (wr == 1) PG8_BAR; }
    }
    PG8_WAIT_V(0);
    if constexpr (!ALIGN_EPI) { if (wr == 0) PG8_BAR; }
    PG8_BAR;
    if constexpr (Epi::AFTER_DRAIN) { E.fused(acc, cur, wr, wc, fr, fq, lds, wid, lane); S.done(cur); }
#undef PG8_SA
#undef PG8_SB
#undef PG8_STAGE
#undef PG8_LDA
#undef PG8_LDB
#undef PG8_MMA
#undef PG8_WAIT_V
#undef PG8_WAIT_L
#undef PG8_BAR
#undef PG8_SCHED
}
}

__device__ __forceinline__ void ld8(const bf16* p, float (&d)[8]) { const u32x4 w = *(const u32x4*)p; d[0] = bflo(w.x); d[1] = bfhi(w.x); d[2] = bflo(w.y); d[3] = bfhi(w.y); d[4] = bflo(w.z); d[5] = bfhi(w.z); d[6] = bflo(w.w); d[7] = bfhi(w.w); }
__device__ void ph_attn_v0(const bf16* proj, const float* rpb, bf16* ao) {
    for (int idx = blockIdx.x * NT + threadIdx.x; idx < M * NH; idx += gridDim.x * NT) {
        const int h = idx >> 15, t = idx & (M - 1), b = t >> 12, s = t & 4095, r = s >> 6, c = s & 63;
        int rs = r - 4; rs = rs < 0 ? 0 : (rs > 56 ? 56 : rs);
        int cs = c - 8; cs = cs < 0 ? 0 : (cs > 48 ? 48 : cs);
        float q[64], o[64];
#pragma unroll
        for (int d = 0; d < 8; ++d) { float tmp[8]; ld8(proj + (size_t)t * DIN + h * 64 + d * 8, tmp);
#pragma unroll
            for (int e = 0; e < 8; ++e) { q[d * 8 + e] = tmp[e] * 0.125f; o[d * 8 + e] = 0.f; } }
        float mx = -1e30f, l = 0.f;
        for (int i = 0; i < 8; ++i) {
            const int kr = rs + i, dr = kr - r + 7;
            const bf16* kbase = proj + ((size_t)(b << 12) + (kr << 6) + cs) * DIN + 512 + h * 64;
            const float* bias = rpb + ((size_t)h * 15 + dr) * 31 + (cs - c + 15);
#pragma unroll 1
            for (int j = 0; j < 16; ++j) { float a = 0.f;
#pragma unroll
                for (int d = 0; d < 8; ++d) { float kk[8]; ld8(kbase + (size_t)j * DIN + d * 8, kk);
#pragma unroll
                    for (int e = 0; e < 8; ++e) a += q[d * 8 + e] * kk[e]; }
                a += bias[j];
                const float mn = fmaxf(mx, a), corr = __expf(mx - mn), pj = __expf(a - mn); mx = mn; l = l * corr + pj;
#pragma unroll
                for (int d = 0; d < 8; ++d) { float vv[8]; ld8(kbase + 512 + (size_t)j * DIN + d * 8, vv);
#pragma unroll
                    for (int e = 0; e < 8; ++e) o[d * 8 + e] = o[d * 8 + e] * corr + pj * vv[e]; } }
        }
        const float inv = 1.0f / l;
#pragma unroll
        for (int d = 0; d < 8; ++d) { u32x4 w; w.x = pk2(o[d * 8] * inv, o[d * 8 + 1] * inv); w.y = pk2(o[d * 8 + 2] * inv, o[d * 8 + 3] * inv); w.z = pk2(o[d * 8 + 4] * inv, o[d * 8 + 5] * inv); w.w = pk2(o[d * 8 + 6] * inv, o[d * 8 + 7] * inv);
            *(u32x4*)(ao + (size_t)t * DATT + h * 64 + d * 8) = w; }
    }
}
__device__ void ph_pool_v0(const bf16* proj, bf16* pooled) {
    for (int idx = blockIdx.x * NT + threadIdx.x; idx < M * (DPOOL / 8); idx += gridDim.x * NT) {
        const int t = idx >> 6, c8 = idx & 63, ch = c8 * 8, g = ch >> 7, half = 1 << g, b = t >> 12, s = t & 4095;
        const int lo = (s - half) < 0 ? 0 : s - half, hi = (s + half) > SEQ ? SEQ : s + half;
        float acc[8] = {0.f, 0.f, 0.f, 0.f, 0.f, 0.f, 0.f, 0.f};
        for (int ss = lo; ss < hi; ++ss) { float v[8]; ld8(proj + ((size_t)(b << 12) + ss) * DIN + 1536 + ch, v);
#pragma unroll
            for (int e = 0; e < 8; ++e) acc[e] += v[e]; }
        float own[8]; ld8(proj + (size_t)t * DIN + 1536 + ch, own); const float inv = 1.0f / (float)(hi - lo);
        u32x4 w; w.x = pk2(acc[0] * inv - own[0], acc[1] * inv - own[1]); w.y = pk2(acc[2] * inv - own[2], acc[3] * inv - own[3]);
        w.z = pk2(acc[4] * inv - own[4], acc[5] * inv - own[5]); w.w = pk2(acc[6] * inv - own[6], acc[7] * inv - own[7]);
        *(u32x4*)(pooled + (size_t)t * DPOOL + ch) = w;
    }
}


#define XB_TMO      128
#define XB_XCNT(j)  (256  + 64 * (j))
#define XB_XSUB(j)  (1280 + 64 * (j))
#define XB_XGEN(j)  (2304 + 64 * (j))
#define XB_TOP      3328
#define XB_TOPGEN   3392
#define XCD_BAR_WORDS 3456
#define XB_SPIN_CAP (1u << 18)
__device__ __forceinline__ unsigned xb_ld(unsigned* p)              { return __hip_atomic_load(p, __ATOMIC_RELAXED, __HIP_MEMORY_SCOPE_AGENT); }
__device__ __forceinline__ unsigned xb_add(unsigned* p, unsigned v) { return __hip_atomic_fetch_add(p, v, __ATOMIC_RELAXED, __HIP_MEMORY_SCOPE_AGENT); }
__device__ __forceinline__ unsigned xb_xcc_id() { return (unsigned)__builtin_amdgcn_s_getreg((3 << 11) | 20) & 0xFu; }
#define XB_SPIN(cond, bar) do { unsigned _sp = 0; while (cond) { __builtin_amdgcn_s_sleep(1); \
    if ((++_sp & 255u) == 0u) { if (xb_ld(&(bar)[XB_TMO])) break; if (_sp > XB_SPIN_CAP) { atomicAdd(&(bar)[XB_TMO], 1u); break; } } } } while (0)
struct XcdBarrier { unsigned* bar; unsigned x; volatile LAS unsigned* st; };
__device__ __forceinline__ XcdBarrier xcd_barrier_post(unsigned* bar, volatile LAS unsigned* st) {
    XcdBarrier b; b.bar = bar; b.x = xb_xcc_id(); b.st = st;
    if (threadIdx.x == 0) (void)xb_add(&bar[XB_XCNT(b.x)], 1u);
    return b;
}
__device__ __forceinline__ void xcd_barrier_complete(unsigned* bar, unsigned x, unsigned& nloc, unsigned& nx) {
    const unsigned G = gridDim.x * gridDim.y * gridDim.z;
    unsigned sum, cnt, mine, sp = 0u;
    for (;;) {
        sum = 0u; cnt = 0u; mine = 0u;
#pragma unroll
        for (unsigned j = 0; j < 16; ++j) { const unsigned c = xb_ld(&bar[XB_XCNT(j)]); sum += c; cnt += (c > 0u) ? 1u : 0u; mine = (j == x) ? c : mine; }
        if (sum == G) break;
        __builtin_amdgcn_s_sleep(1);
        if ((++sp & 255u) == 0u) { if (xb_ld(&bar[XB_TMO])) break; if (sp > XB_SPIN_CAP) { atomicAdd(&bar[XB_TMO], 1u); break; } }
    }
    nloc = mine > 0u ? mine : 1u; nx = cnt > 0u ? cnt : 1u;
}
__device__ __forceinline__ void xcd_barrier(const XcdBarrier& b) {
    asm volatile("s_waitcnt vmcnt(0)" ::: "memory");
    __syncthreads();
    if (threadIdx.x == 0) {
        unsigned* bar = b.bar;
        __builtin_amdgcn_s_waitcnt(0);
        unsigned nloc = b.st[0], nx = b.st[1];
        if (nloc == 0u) { xcd_barrier_complete(bar, b.x, nloc, nx); b.st[0] = nloc; b.st[1] = nx; }
        const unsigned old = xb_add(&bar[XB_XSUB(b.x)], 1u);
        const unsigned gen = old / nloc;
        if (old + 1u == (gen + 1u) * nloc) {
            __builtin_amdgcn_fence(__ATOMIC_RELEASE, "agent");
            asm volatile("s_waitcnt vmcnt(0)" ::: "memory");
            const unsigned og = xb_add(&bar[XB_TOP], 1u);
            const unsigned tg = og / nx;
            if (og + 1u == (tg + 1u) * nx) xb_add(&bar[XB_TOPGEN], 1u);
            else XB_SPIN(xb_ld(&bar[XB_TOPGEN]) == tg, bar);
            __builtin_amdgcn_fence(__ATOMIC_ACQUIRE, "agent");
            xb_add(&bar[XB_XGEN(b.x)], 1u);
            asm volatile("s_waitcnt vmcnt(0)" ::: "memory");
        } else {
            XB_SPIN(xb_ld(&bar[XB_XGEN(b.x)]) == gen, bar);
            __builtin_amdgcn_fence(__ATOMIC_ACQUIRE, "agent");
            asm volatile("s_waitcnt vmcnt(0)" ::: "memory");
        }
    }
    __syncthreads();
}

constexpr int RING_BYTES = 131072, LDSCTL_OFF = RING_BYTES, MISC_OFF = LDSCTL_OFF + 320, LDS_BYTES = 147456;
constexpr int CW_BAR = 4096;
constexpr size_t CTL_ZERO_BYTES = 1 * MiB;

__global__ void __launch_bounds__(NT, 2) fwd_kernel(P p) {
    extern __shared__ __attribute__((aligned(16))) unsigned char lds_raw[];
    LAS unsigned char* lds = (LAS unsigned char*)lds_raw;
    unsigned char* ws = p.ws;
    for (int u = threadIdx.x; u < (LDS_BYTES - LDSCTL_OFF) / 4; u += NT) ((LAS unsigned*)(lds + LDSCTL_OFF))[u] = 0u;
    __syncthreads();
    const XcdBarrier bar = xcd_barrier_post((unsigned*)ws + CW_BAR, (volatile LAS unsigned*)(lds + MISC_OFF) + 8);
#define GRID_BAR() xcd_barrier(bar)
#define GEMM_RUN(g, E) do { pg8::StaticOrder S_; S_.init((g).M, (g).N, (int)gridDim.x, (int)blockIdx.x); pg8::gemm_phase<decltype(E), pg8::StaticOrder, true, true>(lds, (g), S_, (E)); } while (0)
    bf16* U = (bf16*)(ws + WS_U);
    ph_prologue(p, lds); ph_norm_in(p.x, U);
    GRID_BAR();
    { Gemm g{U, (const bf16*)(ws + WS_W1GU), M, NGU, DM}; EpiSwiglu E{(bf16*)(ws + WS_R1)}; GEMM_RUN(g, E); }
    GRID_BAR();
    { Gemm g{(const bf16*)(ws + WS_R1), (const bf16*)(ws + WS_W1D), M, DM, DFF}; EpiStoreF32 E{(float*)(ws + WS_R2), DM}; GEMM_RUN(g, E); }
    GRID_BAR();
    ph_norm_res((const float*)(ws + WS_R2), p.x, p.g1post, 0.5f, p.out, U);
    GRID_BAR();
    { Gemm g{U, (const bf16*)(ws + WS_WIN), M, DIN, DM}; EpiStoreBf16 E{(bf16*)(ws + WS_R1), DIN}; GEMM_RUN(g, E); }
    GRID_BAR();
    ph_attn_v0((const bf16*)(ws + WS_R1), p.rpb, (bf16*)(ws + WS_ATT)); ph_pool_v0((const bf16*)(ws + WS_R1), (bf16*)(ws + WS_POOLED));
    GRID_BAR();
    { Gemm g{(const bf16*)(ws + WS_ATT), (const bf16*)(ws + WS_WBA), M, DM, DATT}; EpiGateMul E{(const bf16*)(ws + WS_R1) + 2048, DIN, (bf16*)(ws + WS_R2)}; GEMM_RUN(g, E); }
    GRID_BAR();
    { Gemm g{(const bf16*)(ws + WS_POOLED), (const bf16*)(ws + WS_WCOMB), M, DM, DPOOL}; EpiGateAdd E{(const bf16*)(ws + WS_R1) + 3072, DIN, (const bf16*)(ws + WS_R2), (bf16*)(ws + WS_MERGED)}; GEMM_RUN(g, E); }
    GRID_BAR();
    { Gemm g{(const bf16*)(ws + WS_MERGED), (const bf16*)(ws + WS_WOUT), M, DM, DM}; EpiStoreF32 E{(float*)(ws + WS_R1), DM}; GEMM_RUN(g, E); }
    GRID_BAR();
    ph_norm_res((const float*)(ws + WS_R1), p.out, p.gmpost, 1.0f, p.out, U);
    GRID_BAR();
    { Gemm g{U, (const bf16*)(ws + WS_W2GU), M, NGU, DM}; EpiSwiglu E{(bf16*)(ws + WS_R1)}; GEMM_RUN(g, E); }
    GRID_BAR();
    { Gemm g{(const bf16*)(ws + WS_R1), (const bf16*)(ws + WS_W2D), M, DM, DFF}; EpiStoreF32 E{(float*)(ws + WS_R2), DM}; GEMM_RUN(g, E); }
    GRID_BAR();
    ph_norm_res((const float*)(ws + WS_R2), p.out, p.g2post, 0.5f, p.out, U); ph_cvt_p(p.p, (bf16*)(ws + WS_R1));
    GRID_BAR();
    { Gemm g{(const bf16*)(ws + WS_R1), (const bf16*)(ws + WS_WPP), M, DM, PLE}; EpiStoreF32 E{(float*)(ws + WS_T2), DM}; GEMM_RUN(g, E); }
    GRID_BAR();
    { Gemm g{U, (const bf16*)(ws + WS_WPG), M, DM, DM}; EpiPle E{(const float*)(ws + WS_T2), (float*)(ws + WS_R2)}; GEMM_RUN(g, E); }
    GRID_BAR();
    ph_norm_res((const float*)(ws + WS_R2), p.out, p.gppost, 1.0f, p.out, nullptr);
}

extern "C" void kernel_launch(void* const* d_in, const int* in_sizes, int n_in, void* d_out, int out_size, void* d_ws, size_t ws_size, hipStream_t stream) {
    static int grid = 0;
    if (grid == 0) {
        if (n_in != 25 || out_size != M * DM || ws_size < 512 * MiB) { fprintf(stderr, "kernel_launch: unexpected shapes n_in %d out %d ws %zu\n", n_in, out_size, ws_size); grid = -1; return; }
        int dev = 0, cus = 0, per_cu = 0;
        if (hipGetDevice(&dev) != hipSuccess || hipDeviceGetAttribute(&cus, hipDeviceAttributeMultiprocessorCount, dev) != hipSuccess) { grid = -1; return; }
        if (hipFuncSetAttribute((const void*)fwd_kernel, hipFuncAttributeMaxDynamicSharedMemorySize, LDS_BYTES) != hipSuccess) { fprintf(stderr, "kernel_launch: hipFuncSetAttribute failed\n"); grid = -1; return; }
        if (hipOccupancyMaxActiveBlocksPerMultiprocessor(&per_cu, (const void*)fwd_kernel, NT, LDS_BYTES) != hipSuccess || per_cu < 1) { fprintf(stderr, "kernel_launch: occupancy query says %d\n", per_cu); per_cu = 1; }
        (void)hipGetLastError();
        grid = cus;
    }
    if (grid < 0) return;
    if (hipMemsetAsync(d_ws, 0, CTL_ZERO_BYTES, stream) != hipSuccess) return;
    P p{};
    const float** f = (const float**)&p;
    for (int i = 0; i < 25; ++i) f[i] = (const float*)d_in[i];
    p.out = (float*)d_out; p.ws = (unsigned char*)d_ws;
    hipLaunchKernelGGL(fwd_kernel, dim3(grid), dim3(NT), LDS_BYTES, stream, p);
}
```

```cpp
#include <hip/hip_runtime.h>
#include <cstdint>
#include <cstdio>

#define LAS __attribute__((address_space(3)))
typedef unsigned short bf16;
typedef short bf16x8 __attribute__((ext_vector_type(8)));
typedef float f32x4 __attribute__((ext_vector_type(4)));
typedef unsigned u32x4 __attribute__((ext_vector_type(4)));
typedef unsigned u32x2 __attribute__((ext_vector_type(2)));

constexpr int BATCH = 8, SEQ = 4096, DM = 1024, M = BATCH * SEQ, DFF = 2816, NGU = 2 * DFF, DIN = 4096;
constexpr int DATT = 512, DPOOL = 512, PLE = 256, NH = 8, HD = 64;
constexpr int PDIN = 3584;
constexpr int PQ = 0, PK = 512, PXP = 1024, PGA = 1536, PGP = 2560;
constexpr float EPS = 1e-6f;
constexpr int NT = 512, NWAVES = 8;

constexpr size_t MiB = 1u << 20;
constexpr size_t WS_W1GU = 1 * MiB, WS_W1D = 12 * MiB, WS_WIN = 18 * MiB, WS_WBA = 26 * MiB, WS_WCOMB = 27 * MiB, WS_WOUT = 28 * MiB;
constexpr size_t WS_W2GU = 30 * MiB, WS_W2D = 41 * MiB, WS_WPG = 47 * MiB, WS_WPP = 49 * MiB;
constexpr size_t WS_U = 64 * MiB;
constexpr size_t WS_ATT = 64 * MiB, WS_POOLED = 96 * MiB;
constexpr size_t WS_VT = 352 * MiB;
constexpr size_t WS_R1 = 128 * MiB;
constexpr size_t WS_T2 = 256 * MiB;
constexpr size_t WS_R2 = 384 * MiB;
constexpr size_t WS_MERGED = 448 * MiB;

struct P {
    const float *x, *p, *g1pre, *g1post, *w1g, *w1u, *w1d, *gmpre, *gmpost, *win, *rpb, *poolw, *pools, *wba, *wbp, *wout;
    const float *g2pre, *g2post, *w2g, *w2u, *w2d, *gppre, *gppost, *wpp, *wpg;
    float* out; unsigned char* ws;
};

__device__ __forceinline__ unsigned f2bf(float f) { unsigned u = __builtin_bit_cast(unsigned, f); return (u + 0x7fffu + ((u >> 16) & 1u)) >> 16; }
typedef float f32x2_t __attribute__((ext_vector_type(2))); typedef __bf16 bf16x2_t __attribute__((ext_vector_type(2)));
__device__ __forceinline__ unsigned pk2(float lo, float hi) { f32x2_t v = {lo, hi}; bf16x2_t b = __builtin_convertvector(v, bf16x2_t); return __builtin_bit_cast(unsigned, b); }
__device__ __forceinline__ float bf2f(unsigned b) { return __builtin_bit_cast(float, b << 16); }
__device__ __forceinline__ float bflo(unsigned w) { return __builtin_bit_cast(float, w << 16); }
__device__ __forceinline__ float bfhi(unsigned w) { return __builtin_bit_cast(float, w & 0xffff0000u); }
__device__ __forceinline__ float sigmoidf_(float v) { return 1.0f / (1.0f + __expf(-v)); }
__device__ __forceinline__ float wave_sum(float v) {
#pragma unroll
    for (int o = 1; o < 64; o <<= 1) v += __shfl_xor(v, o);
    return v;
}

__device__ __forceinline__ void transpose_item(const float* src_lane, int ldsrc, const float* gk, int K, bf16* dst_n0, int k0, LAS float* scr, int lane) {
#pragma unroll 8
    for (int i = 0; i < 32; ++i) { const int kk = 2 * i + (lane >> 5); float v = src_lane[(size_t)(k0 + kk) * ldsrc]; if (gk) v *= gk[k0 + kk]; scr[kk * 33 + (lane & 31)] = v; }
    __builtin_amdgcn_s_waitcnt(0xC07F); asm volatile("" ::: "memory");
    const int c = lane & 7;
#pragma unroll
    for (int j = 0; j < 4; ++j) { const int n = (lane >> 3) + 8 * j; const LAS float* s = scr + (8 * c) * 33 + n;
        u32x4 o; o.x = pk2(s[0 * 33], s[1 * 33]); o.y = pk2(s[2 * 33], s[3 * 33]); o.z = pk2(s[4 * 33], s[5 * 33]); o.w = pk2(s[6 * 33], s[7 * 33]);
        *(u32x4*)(dst_n0 + (size_t)n * K + k0 + 8 * c) = o; }
    __builtin_amdgcn_s_waitcnt(0xC07F); asm volatile("" ::: "memory");
}
__device__ __forceinline__ void transpose_plain(const float* W, int K, int N, const float* gk, bf16* dst, LAS float* scr, int gw, int ngw, int lane, int ldsrc = 0) {
    const int nblk = N / 32, nitems = (K / 64) * nblk; if (ldsrc == 0) ldsrc = N;
    for (int it = gw; it < nitems; it += ngw) { const int kb = it / nblk, nb = it % nblk;
        transpose_item(W + nb * 32 + (lane & 31), ldsrc, gk, K, dst + (size_t)(nb * 32) * K, kb * 64, scr, lane); }
}
__device__ __forceinline__ void transpose_gu(const float* Wg, const float* Wu, const float* gk, bf16* dst, LAS float* scr, int gw, int ngw, int lane) {
    const int nblk = NGU / 32, nitems = (DM / 64) * nblk;
    for (int it = gw; it < nitems; it += ngw) { const int kb = it / nblk, nb = it % nblk; const int w = lane & 31;
        const float* src = (w < 16 ? Wg : Wu) + nb * 16 + (w & 15);
        transpose_item(src, DFF, gk, DM, dst + (size_t)(nb * 32) * DM, kb * 64, scr, lane); }
}
__device__ void ph_prologue(const P& p, LAS unsigned char* lds) {
    const int tid = threadIdx.x, lane = tid & 63, wave = tid >> 6;
    LAS float* scr = (LAS float*)(lds + wave * 16384);
    const int gw = blockIdx.x * NWAVES + wave, ngw = gridDim.x * NWAVES;
    unsigned char* ws = p.ws;
    transpose_gu(p.w1g, p.w1u, p.g1pre, (bf16*)(ws + WS_W1GU), scr, gw, ngw, lane);
    transpose_plain(p.w1d, DFF, DM, nullptr, (bf16*)(ws + WS_W1D), scr, gw, ngw, lane);
    transpose_plain(p.win, DM, 1024, p.gmpre, (bf16*)(ws + WS_WIN), scr, gw, ngw, lane, DIN);
    transpose_plain(p.win + 1536, DM, 2560, p.gmpre, (bf16*)(ws + WS_WIN) + (size_t)1024 * DM, scr, gw, ngw, lane, DIN);
    transpose_plain(p.win + 1024, DM, 512, p.gmpre, (bf16*)(ws + WS_WIN) + (size_t)PDIN * DM, scr, gw, ngw, lane, DIN);
    transpose_plain(p.wba, DATT, DM, nullptr, (bf16*)(ws + WS_WBA), scr, gw, ngw, lane);
    transpose_plain(p.wout, DM, DM, nullptr, (bf16*)(ws + WS_WOUT), scr, gw, ngw, lane);
    transpose_gu(p.w2g, p.w2u, p.g2pre, (bf16*)(ws + WS_W2GU), scr, gw, ngw, lane);
    transpose_plain(p.w2d, DFF, DM, nullptr, (bf16*)(ws + WS_W2D), scr, gw, ngw, lane);
    transpose_plain(p.wpg, DM, DM, p.gppre, (bf16*)(ws + WS_WPG), scr, gw, ngw, lane);
    transpose_plain(p.wpp, PLE, DM, nullptr, (bf16*)(ws + WS_WPP), scr, gw, ngw, lane);
    bf16* wc = (bf16*)(ws + WS_WCOMB);
    for (int idx = blockIdx.x * NT + tid; idx < DPOOL * DM; idx += gridDim.x * NT) {
        const int n = idx & (DM - 1), k = idx >> 10, g = k >> 7, kl = k & 127;
        const float* pw = p.poolw + ((size_t)g * 128 + kl) * 128; const float* ps = p.pools + g * 128; const float* wb = p.wbp + (size_t)(g * 128) * DM + n;
        float s = 0.f;
        for (int j = 0; j < 128; ++j) s += pw[j] * ps[j] * wb[(size_t)j * DM];
        wc[(size_t)n * DPOOL + k] = (bf16)f2bf(s);
    }
}

__device__ __forceinline__ void row_load(const float* row, int lane, f32x4 (&v)[4]) {
#pragma unroll
    for (int j = 0; j < 4; ++j) v[j] = *((const f32x4*)row + lane + 64 * j);
}
__device__ __forceinline__ float row_ss(const f32x4 (&v)[4]) {
    float s = 0.f;
#pragma unroll
    for (int j = 0; j < 4; ++j) s += (v[j].x * v[j].x + v[j].y * v[j].y) + (v[j].z * v[j].z + v[j].w * v[j].w);
    return wave_sum(s);
}
__device__ __forceinline__ void row_store_bf16(bf16* row, int lane, const f32x4 (&v)[4], float sc) {
#pragma unroll
    for (int j = 0; j < 4; ++j) { u32x2 w; w.x = pk2(v[j].x * sc, v[j].y * sc); w.y = pk2(v[j].z * sc, v[j].w * sc); *((u32x2*)row + lane + 64 * j) = w; }
}
__device__ void ph_norm_in(const float* x, bf16* u) {
    const int lane = threadIdx.x & 63, gw = blockIdx.x * NWAVES + (threadIdx.x >> 6), ngw = gridDim.x * NWAVES;
    for (int r = gw; r < M; r += ngw) { f32x4 v[4]; row_load(x + (size_t)r * DM, lane, v);
        const float rs = rsqrtf(row_ss(v) * (1.0f / DM) + EPS); row_store_bf16(u + (size_t)r * DM, lane, v, rs); }
}
__device__ void ph_norm_res(const float* f, const float* hin, const float* g, float scale, float* hout, bf16* u) {
    const int lane = threadIdx.x & 63, gw = blockIdx.x * NWAVES + (threadIdx.x >> 6), ngw = gridDim.x * NWAVES;
    f32x4 gv[4]; row_load(g, lane, gv);
    for (int r = gw; r < M; r += ngw) { f32x4 v[4], h[4]; row_load(f + (size_t)r * DM, lane, v); row_load(hin + (size_t)r * DM, lane, h);
        const float rs = rsqrtf(row_ss(v) * (1.0f / DM) + EPS) * scale;
#pragma unroll
        for (int j = 0; j < 4; ++j) { h[j] = h[j] + v[j] * gv[j] * rs; *((f32x4*)(hout + (size_t)r * DM) + lane + 64 * j) = h[j]; }
        if (u) { const float r2 = rsqrtf(row_ss(h) * (1.0f / DM) + EPS); row_store_bf16(u + (size_t)r * DM, lane, h, r2); }
    }
}
__device__ void ph_cvt_p(const float* p, bf16* o) {
    for (size_t i = (size_t)blockIdx.x * NT + threadIdx.x; i < (size_t)M * PLE / 4; i += (size_t)gridDim.x * NT) {
        const f32x4 v = *((const f32x4*)p + i); u32x2 w; w.x = pk2(v.x, v.y); w.y = pk2(v.z, v.w); *((u32x2*)o + i) = w; }
}

namespace pg8 {
#define PG8_LAS __attribute__((address_space(3)))
typedef unsigned short bf16_t;
typedef short bf16x8 __attribute__((ext_vector_type(8)));
typedef float f32x4 __attribute__((ext_vector_type(4)));
typedef unsigned u32x4 __attribute__((ext_vector_type(4)));
constexpr int BM = 256, BK = 64, HALF = 128, HTB = HALF * BK * 2  , STAGE_BYTES = 8 * HTB, NXCD = 8, WGM = 8;

__host__ __device__ __forceinline__ int lds_byte(int r, int c) { const int st = (r >> 4) * 2 + (c >> 5), rr = r & 15, cc = c & 31, ob = rr * 64 + cc * 2; return st * 1024 + (ob ^ (((ob >> 9) & 1) << 5)); }
__host__ __device__ __forceinline__ void stage_rc(int b, int& R, int& C) { const int st = b / 1024, sb = b % 1024, swz = sb ^ (((sb >> 9) & 1) << 5); R = (st >> 1) * 16 + swz / 64; C = (st & 1) * 32 + (swz % 64) / 2; }
__host__ __device__ __forceinline__ int perm32(int rho) { const int n = rho >> 4, i = rho & 15; return 8 * (i >> 2) + 4 * n + (i & 3); }

struct Unit { int pm, pn; };
struct Gemm { const bf16_t* A; const bf16_t* Bt; int M, N, K; };

struct StaticOrder {
    int nM, nN, nwg, G, c;
    __host__ __device__ void init(int M, int N, int G_, int c_) { nM = M / BM; nN = N / BM; nwg = nM * nN; G = G_; c = c_; }
    __host__ __device__ bool next(int i, Unit& u) const {
        const long L = (long)i * G + c; if (L >= nwg) return false;
        int wgid = (int)L; { const int q = nwg / NXCD, r = nwg % NXCD, xcd = wgid % NXCD, off = wgid / NXCD; wgid = (xcd < r ? xcd * (q + 1) : r * (q + 1) + (xcd - r) * q) + off; }
        const int nig = WGM * nN, gid = wgid / nig, fm = gid * WGM, gsz = (nM - fm) < WGM ? (nM - fm) : WGM;
        u.pm = fm + ((wgid % nig) % gsz); u.pn = (wgid % nig) / gsz; return true;
    }
    __device__ __forceinline__ void a_ready(const Unit&) const {}
    __device__ __forceinline__ void done(const Unit&) const {}
};

}
using pg8::Unit; using pg8::Gemm;

template <class Epi>
__device__ __forceinline__ void gemm_simple(LAS unsigned char* lds, const Gemm g, const Epi& E) {
    const int tid = threadIdx.x, wid = tid >> 6, lane = tid & 63, wr = wid >> 2, wc = wid & 3, fr = lane & 15, fq = lane >> 4;
    constexpr int RS = 144;
    LAS unsigned char* sA = lds; LAS unsigned char* sB = lds + 256 * RS;
    const int nN = g.N / 256, nU = (g.M / 256) * nN;
    for (int unit = blockIdx.x; unit < nU; unit += gridDim.x) {
        Unit u; u.pm = unit / nN; u.pn = unit % nN;
        f32x4 acc[2][2][4][2];
#pragma unroll
        for (int a = 0; a < 2; ++a)
#pragma unroll
            for (int b = 0; b < 2; ++b)
#pragma unroll
                for (int m = 0; m < 4; ++m)
#pragma unroll
                    for (int n = 0; n < 2; ++n) acc[a][b][m][n] = (f32x4){0.f, 0.f, 0.f, 0.f};
        const bf16* Ab = g.A + (size_t)u.pm * 256 * g.K; const bf16* Bb = g.Bt + (size_t)u.pn * 256 * g.K;
        for (int k0 = 0; k0 < g.K; k0 += 64) {
#pragma unroll
            for (int i = 0; i < 4; ++i) { const int ch = tid + NT * i, row = ch >> 3, cc = ch & 7;
                const u32x4 va = *(const u32x4*)(Ab + (size_t)row * g.K + k0 + cc * 8); const u32x4 vb = *(const u32x4*)(Bb + (size_t)row * g.K + k0 + cc * 8);
                *(LAS u32x4*)(sA + row * RS + cc * 16) = va; *(LAS u32x4*)(sB + row * RS + cc * 16) = vb; }
            __syncthreads();
#pragma unroll
            for (int ks = 0; ks < 2; ++ks) {
                bf16x8 At[2][4], Bf[2][2];
#pragma unroll
                for (int ai = 0; ai < 2; ++ai)
#pragma unroll
                    for (int m = 0; m < 4; ++m) At[ai][m] = *(const LAS bf16x8*)(sA + (128 * ai + 64 * wr + 16 * m + fr) * RS + ks * 64 + fq * 16);
#pragma unroll
                for (int bj = 0; bj < 2; ++bj)
#pragma unroll
                    for (int n = 0; n < 2; ++n) Bf[bj][n] = *(const LAS bf16x8*)(sB + (128 * bj + 32 * wc + 16 * n + fr) * RS + ks * 64 + fq * 16);
#pragma unroll
                for (int ai = 0; ai < 2; ++ai)
#pragma unroll
                    for (int bj = 0; bj < 2; ++bj)
#pragma unroll
                        for (int m = 0; m < 4; ++m)
#pragma unroll
                            for (int n = 0; n < 2; ++n) acc[ai][bj][m][n] = __builtin_amdgcn_mfma_f32_16x16x32_bf16(Bf[bj][n], At[ai][m], acc[ai][bj][m][n], 0, 0, 0);
            }
            __syncthreads();
        }
        E(acc, u, wr, wc, fr, fq);
    }
}

#define EPI_LOOP_BEGIN \
    _Pragma("unroll") for (int ai = 0; ai < 2; ++ai) _Pragma("unroll") for (int m = 0; m < 4; ++m) { const int row = u.pm * 256 + ai * 128 + wr * 64 + m * 16 + fr; \
    _Pragma("unroll") for (int bj = 0; bj < 2; ++bj)
struct EpiSwiglu {
    static constexpr bool PERM = false, AFTER_DRAIN = false;
    bf16* O;
    __device__ __forceinline__ void operator()(const f32x4 (&acc)[2][2][4][2], const Unit& u, int wr, int wc, int fr, int fq) const {
        EPI_LOOP_BEGIN { const int col = u.pn * 128 + bj * 64 + wc * 16 + 4 * fq; const f32x4 G = acc[ai][bj][m][0], U = acc[ai][bj][m][1]; float o[4];
#pragma unroll
            for (int i = 0; i < 4; ++i) o[i] = G[i] * sigmoidf_(G[i]) * U[i];
            u32x2 w; w.x = pk2(o[0], o[1]); w.y = pk2(o[2], o[3]); *(u32x2*)(O + (size_t)row * DFF + col) = w; } }
    }
};
struct EpiStoreF32 {
    static constexpr bool PERM = false, AFTER_DRAIN = false;
    float* C; int ldc;
    __device__ __forceinline__ void operator()(const f32x4 (&acc)[2][2][4][2], const Unit& u, int wr, int wc, int fr, int fq) const {
        EPI_LOOP_BEGIN {
#pragma unroll
            for (int n = 0; n < 2; ++n) { const int col = u.pn * 256 + bj * 128 + wc * 32 + n * 16 + 4 * fq; *(f32x4*)(C + (size_t)row * ldc + col) = acc[ai][bj][m][n]; } } }
    }
};
struct EpiStoreBf16 {
    static constexpr bool PERM = false, AFTER_DRAIN = false;
    bf16* C; int ldc;
    __device__ __forceinline__ void operator()(const f32x4 (&acc)[2][2][4][2], const Unit& u, int wr, int wc, int fr, int fq) const {
        EPI_LOOP_BEGIN {
#pragma unroll
            for (int n = 0; n < 2; ++n) { const int col = u.pn * 256 + bj * 128 + wc * 32 + n * 16 + 4 * fq; const f32x4 v = acc[ai][bj][m][n];
                u32x2 w; w.x = pk2(v[0], v[1]); w.y = pk2(v[2], v[3]); *(u32x2*)(C + (size_t)row * ldc + col) = w; } } }
    }
};
struct EpiGateMul {
    static constexpr bool PERM = false, AFTER_DRAIN = false;
    const bf16* gate; int ldg; bf16* T;
    __device__ __forceinline__ void operator()(const f32x4 (&acc)[2][2][4][2], const Unit& u, int wr, int wc, int fr, int fq) const {
        EPI_LOOP_BEGIN {
#pragma unroll
            for (int n = 0; n < 2; ++n) { const int col = u.pn * 256 + bj * 128 + wc * 32 + n * 16 + 4 * fq; const f32x4 v = acc[ai][bj][m][n];
                const u32x2 gw = *(const u32x2*)(gate + (size_t)row * ldg + col);
                const float o0 = sigmoidf_(bflo(gw.x)) * v[0], o1 = sigmoidf_(bfhi(gw.x)) * v[1], o2 = sigmoidf_(bflo(gw.y)) * v[2], o3 = sigmoidf_(bfhi(gw.y)) * v[3];
                u32x2 w; w.x = pk2(o0, o1); w.y = pk2(o2, o3); *(u32x2*)(T + (size_t)row * DM + col) = w; } } }
    }
};
struct EpiGateAdd {
    static constexpr bool PERM = false, AFTER_DRAIN = false;
    const bf16* gate; int ldg; const bf16* T; bf16* Mg;
    __device__ __forceinline__ void operator()(const f32x4 (&acc)[2][2][4][2], const Unit& u, int wr, int wc, int fr, int fq) const {
        EPI_LOOP_BEGIN {
#pragma unroll
            for (int n = 0; n < 2; ++n) { const int col = u.pn * 256 + bj * 128 + wc * 32 + n * 16 + 4 * fq; const f32x4 v = acc[ai][bj][m][n];
                const u32x2 gw = *(const u32x2*)(gate + (size_t)row * ldg + col); const u32x2 tw = *(const u32x2*)(T + (size_t)row * DM + col);
                const float o0 = bflo(tw.x) + sigmoidf_(bflo(gw.x)) * v[0], o1 = bfhi(tw.x) + sigmoidf_(bfhi(gw.x)) * v[1], o2 = bflo(tw.y) + sigmoidf_(bflo(gw.y)) * v[2], o3 = bfhi(tw.y) + sigmoidf_(bfhi(gw.y)) * v[3];
                u32x2 w; w.x = pk2(o0, o1); w.y = pk2(o2, o3); *(u32x2*)(Mg + (size_t)row * DM + col) = w; } } }
    }
};
struct EpiPle {
    static constexpr bool PERM = false, AFTER_DRAIN = false;
    const float* T2; float* E;
    __device__ __forceinline__ void operator()(const f32x4 (&acc)[2][2][4][2], const Unit& u, int wr, int wc, int fr, int fq) const {
        EPI_LOOP_BEGIN {
#pragma unroll
            for (int n = 0; n < 2; ++n) { const int col = u.pn * 256 + bj * 128 + wc * 32 + n * 16 + 4 * fq; const f32x4 v = acc[ai][bj][m][n];
                const f32x4 t = *(const f32x4*)(T2 + (size_t)row * DM + col); f32x4 o;
#pragma unroll
                for (int i = 0; i < 4; ++i) o[i] = t[i] * sigmoidf_(v[i]);
                *(f32x4*)(E + (size_t)row * DM + col) = o; } } }
    }
};

namespace pg8 {
template <class Epi, class Sched, bool ALIGN_EPI = false, bool SP2 = false>
__device__ __forceinline__ void gemm_phase(PG8_LAS unsigned char* lds, const Gemm g, const Sched& S, const Epi& E) {
    const int tid = threadIdx.x, wid = __builtin_amdgcn_readfirstlane(tid >> 6), lane = tid & 63, wr = wid >> 2, wc = wid & 3, fr = lane & 15, fq = lane >> 4;
    const int K = g.K, nt = K / BK;
    unsigned voffA[2], voffB[2];
#pragma unroll
    for (int i = 0; i < 2; ++i) { int R, C; stage_rc(tid * 16 + i * 8192, R, C); const int Rb = Epi::PERM ? ((R & ~31) + perm32(R & 31)) : R;
        voffA[i] = (unsigned)(R * K + C) * 2u; voffB[i] = (unsigned)(Rb * K + C) * 2u; }
    const size_t kstep = (size_t)(BK * 2);
    const size_t hstep = (size_t)HALF * K * 2;
    const size_t tstep = 2 * hstep;
    const unsigned ldsw = (unsigned)wid * 1024u;
    const int aoff = lds_byte(wr * 64 + fr, fq * 8), boff = lds_byte(wc * 32 + fr, fq * 8);
#define PG8_SA(b, h) (((b) * 2 + (h)) * HTB)
#define PG8_SB(b, h) ((4 + (b) * 2 + (h)) * HTB)
#define PG8_STAGE(bufoff, gbase, voff) do { _Pragma("unroll") for (int _i = 0; _i < 2; ++_i) \
        __builtin_amdgcn_global_load_lds((const unsigned*)((const char*)(gbase) + (voff)[_i]), (PG8_LAS unsigned*)(lds + (bufoff) + ldsw + _i * 8192), 16, 0, 0); } while (0)
#define PG8_LDA(dst, b, h) do { _Pragma("unroll") for (int m = 0; m < 4; ++m) _Pragma("unroll") for (int k = 0; k < 2; ++k) dst[m][k] = *(const PG8_LAS bf16x8*)(lds + PG8_SA(b, h) + aoff + m * 2048 + k * 1024); } while (0)
#define PG8_LDB(dst, b, h) do { _Pragma("unroll") for (int n = 0; n < 2; ++n) _Pragma("unroll") for (int k = 0; k < 2; ++k) dst[n][k] = *(const PG8_LAS bf16x8*)(lds + PG8_SB(b, h) + boff + n * 2048 + k * 1024); } while (0)
#define PG8_MMA(ai, bj, At, Bt) do { __builtin_amdgcn_s_setprio(1); _Pragma("unroll") for (int m = 0; m < 4; ++m) _Pragma("unroll") for (int n = 0; n < 2; ++n) _Pragma("unroll") for (int k = 0; k < 2; ++k) \
        acc[ai][bj][m][n] = __builtin_amdgcn_mfma_f32_16x16x32_bf16(Bt[n][k], At[m][k], acc[ai][bj][m][n], 0, 0, 0); __builtin_amdgcn_s_setprio(0); } while (0)
#define PG8_WAIT_V(n) asm volatile("s_waitcnt vmcnt(" #n ")" ::: "memory")
#define PG8_WAIT_L(n) asm volatile("s_waitcnt lgkmcnt(" #n ")" ::: "memory")
#define PG8_BAR __builtin_amdgcn_s_barrier()
#define PG8_SCHED __builtin_amdgcn_sched_barrier(0)
    Unit cur, nxt; int ui = 0;
    if (!S.next(0, cur)) return;
    f32x4 acc[2][2][4][2];
#pragma unroll
    for (int a = 0; a < 2; ++a)
#pragma unroll
        for (int b = 0; b < 2; ++b)
#pragma unroll
            for (int m = 0; m < 4; ++m)
#pragma unroll
                for (int n = 0; n < 2; ++n) acc[a][b][m][n] = (f32x4){0.f, 0.f, 0.f, 0.f};
    bf16x8 At[4][2], B0[2][2], B1[2][2];
    const char* cA = (const char*)g.A + (size_t)cur.pm * tstep; const char* cB = (const char*)g.Bt + (size_t)cur.pn * tstep;
    S.a_ready(cur);
    if constexpr (SP2) {
        PG8_STAGE(PG8_SB(0, 0), cB, voffB); PG8_STAGE(PG8_SB(0, 1), cB + hstep, voffB); PG8_STAGE(PG8_SA(0, 0), cA, voffA); PG8_STAGE(PG8_SA(0, 1), cA + hstep, voffA);
        if (wr == 1) PG8_BAR;
        PG8_WAIT_V(2); PG8_BAR;
        PG8_STAGE(PG8_SB(1, 0), cB + kstep, voffB); PG8_STAGE(PG8_SA(1, 0), cA + kstep, voffA); PG8_STAGE(PG8_SB(1, 1), cB + hstep + kstep, voffB);
        PG8_WAIT_V(6); PG8_BAR;
    } else {
        PG8_STAGE(PG8_SB(0, 0), cB, voffB); PG8_STAGE(PG8_SA(0, 0), cA, voffA); PG8_STAGE(PG8_SB(0, 1), cB + hstep, voffB); PG8_STAGE(PG8_SA(0, 1), cA + hstep, voffA);
        if (wr == 1) PG8_BAR;
        PG8_WAIT_V(4); PG8_BAR;
        PG8_STAGE(PG8_SB(1, 0), cB + kstep, voffB); PG8_STAGE(PG8_SA(1, 0), cA + kstep, voffA); PG8_STAGE(PG8_SB(1, 1), cB + hstep + kstep, voffB);
        PG8_WAIT_V(6); PG8_BAR;
    }
    for (;;) {
        const bool has_next = S.next(ui + 1, nxt);
        const char* nA = has_next ? (const char*)g.A + (size_t)nxt.pm * tstep : cA; const char* nB = has_next ? (const char*)g.Bt + (size_t)nxt.pn * tstep : cB;
        for (int t = 0; t < nt; t += 2) {
            const bool last = (t == nt - 2);
            const char* a1 = cA + (size_t)(t + 1) * kstep;
            const char* a2 = last ? nA : cA + (size_t)(t + 2) * kstep; const char* b2 = last ? nB : cB + (size_t)(t + 2) * kstep;
            const char* a3 = a2 + kstep; const char* b3 = b2 + kstep;
            if (last && has_next) S.a_ready(nxt);
            if constexpr (SP2) {
            PG8_LDB(B0, 0, 0); PG8_LDB(B1, 0, 1); PG8_SCHED; PG8_LDA(At, 0, 0); PG8_STAGE(PG8_SA(1, 1), a1 + hstep, voffA);
            PG8_WAIT_V(8); PG8_WAIT_L(0); PG8_BAR; PG8_MMA(0, 0, At, B0); PG8_MMA(0, 1, At, B1); PG8_BAR; PG8_SCHED;
            PG8_LDA(At, 0, 1); PG8_STAGE(PG8_SB(0, 0), b2, voffB); PG8_STAGE(PG8_SB(0, 1), b2 + hstep, voffB); PG8_STAGE(PG8_SA(0, 0), a2, voffA);
            PG8_WAIT_V(8); PG8_WAIT_L(0); PG8_BAR; PG8_MMA(1, 0, At, B0); PG8_MMA(1, 1, At, B1); PG8_BAR; PG8_SCHED;
            PG8_LDB(B0, 1, 0); PG8_LDB(B1, 1, 1); PG8_SCHED; PG8_LDA(At, 1, 0); PG8_STAGE(PG8_SA(0, 1), a2 + hstep, voffA);
            PG8_WAIT_V(8); PG8_WAIT_L(0); PG8_BAR; PG8_MMA(0, 0, At, B0); PG8_MMA(0, 1, At, B1); PG8_BAR; PG8_SCHED;
            PG8_LDA(At, 1, 1); PG8_STAGE(PG8_SB(1, 0), b3, voffB); PG8_STAGE(PG8_SB(1, 1), b3 + hstep, voffB); PG8_STAGE(PG8_SA(1, 0), a3, voffA);
            PG8_WAIT_V(8); PG8_WAIT_L(0); PG8_BAR; PG8_MMA(1, 0, At, B0); PG8_MMA(1, 1, At, B1); PG8_BAR; PG8_SCHED;
            } else {
            PG8_LDB(B0, 0, 0); PG8_SCHED; PG8_LDA(At, 0, 0); PG8_STAGE(PG8_SA(1, 1), a1 + hstep, voffA);
            PG8_WAIT_L(8); PG8_BAR; PG8_WAIT_L(0); PG8_MMA(0, 0, At, B0); PG8_BAR; PG8_SCHED;
            PG8_LDB(B1, 0, 1); PG8_STAGE(PG8_SB(0, 0), b2, voffB);
            PG8_BAR; PG8_WAIT_L(0); PG8_MMA(0, 1, At, B1); PG8_BAR;
            PG8_LDA(At, 0, 1); PG8_STAGE(PG8_SA(0, 0), a2, voffA);
            PG8_BAR; PG8_WAIT_L(0); PG8_MMA(1, 0, At, B0); PG8_BAR; PG8_SCHED;
            PG8_STAGE(PG8_SB(0, 1), b2 + hstep, voffB);
            PG8_WAIT_V(6); PG8_BAR; PG8_MMA(1, 1, At, B1); PG8_BAR;
            PG8_LDB(B0, 1, 0); PG8_SCHED; PG8_LDA(At, 1, 0); PG8_STAGE(PG8_SA(0, 1), a2 + hstep, voffA);
            PG8_WAIT_L(8); PG8_BAR; PG8_WAIT_L(0); PG8_MMA(0, 0, At, B0); PG8_BAR; PG8_SCHED;
            PG8_LDB(B1, 1, 1); PG8_STAGE(PG8_SB(1, 0), b3, voffB);
            PG8_BAR; PG8_WAIT_L(0); PG8_MMA(0, 1, At, B1); PG8_BAR;
            PG8_LDA(At, 1, 1); PG8_STAGE(PG8_SA(1, 0), a3, voffA);
            PG8_BAR; PG8_WAIT_L(0); PG8_MMA(1, 0, At, B0); PG8_BAR; PG8_SCHED;
            PG8_STAGE(PG8_SB(1, 1), b3 + hstep, voffB);
            PG8_WAIT_V(6); PG8_BAR; PG8_MMA(1, 1, At, B1); PG8_BAR;
            }
        }
        if constexpr (ALIGN_EPI) { if (wr == 0) PG8_BAR; }
        if constexpr (!Epi::AFTER_DRAIN) { E(acc, cur, wr, wc, fr, fq); S.done(cur); }
        if (!has_next) break;
#pragma unroll
        for (int a = 0; a < 2; ++a)
#pragma unroll
            for (int b = 0; b < 2; ++b)
#pragma unroll
                for (int m = 0; m < 4; ++m)
#pragma unroll
                    for (int n = 0; n < 2; ++n) acc[a][b][m][n] = (f32x4){0.f, 0.f, 0.f, 0.f};
        cur = nxt; cA = nA; cB = nB; ++ui;
        if constexpr (ALIGN_EPI) { if (wr == 1) PG8_BAR; }
    }
    PG8_WAIT_V(0);
    if constexpr (!ALIGN_EPI) { if (wr == 0) PG8_BAR; }
    PG8_BAR;
    if constexpr (Epi::AFTER_DRAIN) { E.fused(acc, cur, wr, wc, fr, fq, lds, wid, lane); S.done(cur); }
#undef PG8_SA
#undef PG8_SB
#undef PG8_STAGE
#undef PG8_LDA
#undef PG8_LDB
#undef PG8_MMA
#undef PG8_WAIT_V
#undef PG8_WAIT_L
#undef PG8_BAR
#undef PG8_SCHED
}
}

__device__ void ph_attn(const bf16* proj, const bf16* vT, const float* rpb, bf16* ao, int vcu, int nvcu) {
    const int tid = threadIdx.x, wave = tid >> 6, lane = tid & 63, fr = lane & 15, fq = lane >> 4;
    const int jb = wave & 3, rpar = wave >> 2;
    const int kc0 = jb == 0 ? 0 : (jb == 1 ? 8 : (jb == 2 ? 24 : 32));
    const int c = 16 * jb + fr; int cs = c - 8; cs = cs < 0 ? 0 : (cs > 48 ? 48 : cs);
    for (int wu = vcu; wu < BATCH * NH * 4; wu += nvcu) {
        const int bh = wu >> 2, b = bh >> 3, h = bh & 7, rbase = (wu & 3) * 16;
        for (int it = 0; it < 8; ++it) {
            const int r = rbase + 2 * it + rpar; int rs = r - 4; rs = rs < 0 ? 0 : (rs > 56 ? 56 : rs);
            const size_t qtok = (size_t)b * SEQ + r * 64 + c;
            bf16x8 qf[2];
#pragma unroll
            for (int ks = 0; ks < 2; ++ks) qf[ks] = *(const bf16x8*)(proj + qtok * PDIN + PQ + h * 64 + ks * 32 + fq * 8);
            f32x4 sc[8][2];
#pragma unroll
            for (int i = 0; i < 8; ++i)
#pragma unroll
                for (int t = 0; t < 2; ++t) {
                    const size_t ktok = (size_t)b * SEQ + (rs + i) * 64 + kc0 + 8 * (fr >> 2) + 4 * t + (fr & 3);
                    const bf16* kp = proj + ktok * PDIN + PK + h * 64 + fq * 8;
                    const bf16x8 k0 = *(const bf16x8*)kp, k1 = *(const bf16x8*)(kp + 32);
                    f32x4 a = (f32x4){0.f, 0.f, 0.f, 0.f};
                    a = __builtin_amdgcn_mfma_f32_16x16x32_bf16(k0, qf[0], a, 0, 0, 0);
                    a = __builtin_amdgcn_mfma_f32_16x16x32_bf16(k1, qf[1], a, 0, 0, 0);
                    sc[i][t] = a;
                }
            float mx = -1e30f;
#pragma unroll
            for (int i = 0; i < 8; ++i) { const float* brow = rpb + ((size_t)h * 15 + (rs + i - r + 7)) * 31;
#pragma unroll
                for (int t = 0; t < 2; ++t)
#pragma unroll
                    for (int e = 0; e < 4; ++e) { const int kc = kc0 + 8 * fq + 4 * t + e; const bool valid = (kc >= cs) && (kc < cs + 16);
                        int dc = kc - c + 15; dc = dc < 0 ? 0 : (dc > 30 ? 30 : dc);
                        const float s = valid ? sc[i][t][e] * 0.125f + brow[dc] : -1e30f; sc[i][t][e] = s; mx = fmaxf(mx, s); } }
            mx = fmaxf(mx, __shfl_xor(mx, 16)); mx = fmaxf(mx, __shfl_xor(mx, 32));
            float l = 0.f;
#pragma unroll
            for (int i = 0; i < 8; ++i)
#pragma unroll
                for (int t = 0; t < 2; ++t)
#pragma unroll
                    for (int e = 0; e < 4; ++e) { const float pv = __expf(sc[i][t][e] - mx); sc[i][t][e] = pv; l += pv; }
            l += __shfl_xor(l, 16); l += __shfl_xor(l, 32);
            const float inv = 1.0f / l;
            bf16x8 pf[8];
#pragma unroll
            for (int i = 0; i < 8; ++i) { u32x4 w; w.x = pk2(sc[i][0][0] * inv, sc[i][0][1] * inv); w.y = pk2(sc[i][0][2] * inv, sc[i][0][3] * inv);
                w.z = pk2(sc[i][1][0] * inv, sc[i][1][1] * inv); w.w = pk2(sc[i][1][2] * inv, sc[i][1][3] * inv); pf[i] = __builtin_bit_cast(bf16x8, w); }
#pragma unroll
            for (int dt = 0; dt < 4; ++dt) {
                const bf16* vp = vT + (size_t)(h * 64 + dt * 16 + fr) * M + (size_t)b * SEQ + rs * 64 + kc0 + 8 * fq;
                f32x4 o = (f32x4){0.f, 0.f, 0.f, 0.f};
#pragma unroll
                for (int i = 0; i < 8; ++i) { const bf16x8 vf = *(const bf16x8*)(vp + i * 64); o = __builtin_amdgcn_mfma_f32_16x16x32_bf16(vf, pf[i], o, 0, 0, 0); }
                u32x2 w; w.x = pk2(o[0], o[1]); w.y = pk2(o[2], o[3]);
                *(u32x2*)(ao + qtok * DATT + h * 64 + dt * 16 + 4 * fq) = w;
            }
        }
    }
}
__device__ __forceinline__ void ld8(const bf16* p, float (&d)[8]) { const u32x4 w = *(const u32x4*)p; d[0] = bflo(w.x); d[1] = bfhi(w.x); d[2] = bflo(w.y); d[3] = bfhi(w.y); d[4] = bflo(w.z); d[5] = bfhi(w.z); d[6] = bflo(w.w); d[7] = bfhi(w.w); }
__device__ void ph_pool_v0(const bf16* proj, bf16* pooled) {
    for (int idx = blockIdx.x * NT + threadIdx.x; idx < M * (DPOOL / 8); idx += gridDim.x * NT) {
        const int t = idx >> 6, c8 = idx & 63, ch = c8 * 8, g = ch >> 7, half = 1 << g, b = t >> 12, s = t & 4095;
        const int lo = (s - half) < 0 ? 0 : s - half, hi = (s + half) > SEQ ? SEQ : s + half;
        float acc[8] = {0.f, 0.f, 0.f, 0.f, 0.f, 0.f, 0.f, 0.f};
        for (int ss = lo; ss < hi; ++ss) { float v[8]; ld8(proj + ((size_t)(b << 12) + ss) * PDIN + PXP + ch, v);
#pragma unroll
            for (int e = 0; e < 8; ++e) acc[e] += v[e]; }
        float own[8]; ld8(proj + (size_t)t * PDIN + PXP + ch, own); const float inv = 1.0f / (float)(hi - lo);
        u32x4 w; w.x = pk2(acc[0] * inv - own[0], acc[1] * inv - own[1]); w.y = pk2(acc[2] * inv - own[2], acc[3] * inv - own[3]);
        w.z = pk2(acc[4] * inv - own[4], acc[5] * inv - own[5]); w.w = pk2(acc[6] * inv - own[6], acc[7] * inv - own[7]);
        *(u32x4*)(pooled + (size_t)t * DPOOL + ch) = w;
    }
}

#define XB_TMO      128
#define XB_XCNT(j)  (256  + 64 * (j))
#define XB_XSUB(j)  (1280 + 64 * (j))
#define XB_XGEN(j)  (2304 + 64 * (j))
#define XB_TOP      3328
#define XB_TOPGEN   3392
#define XCD_BAR_WORDS 3456
#define XB_SPIN_CAP (1u << 18)
__device__ __forceinline__ unsigned xb_ld(unsigned* p)              { return __hip_atomic_load(p, __ATOMIC_RELAXED, __HIP_MEMORY_SCOPE_AGENT); }
__device__ __forceinline__ unsigned xb_add(unsigned* p, unsigned v) { return __hip_atomic_fetch_add(p, v, __ATOMIC_RELAXED, __HIP_MEMORY_SCOPE_AGENT); }
__device__ __forceinline__ unsigned xb_xcc_id() { return (unsigned)__builtin_amdgcn_s_getreg((3 << 11) | 20) & 0xFu; }
#define XB_SPIN(cond, bar) do { unsigned _sp = 0; while (cond) { __builtin_amdgcn_s_sleep(1); \
    if ((++_sp & 255u) == 0u) { if (xb_ld(&(bar)[XB_TMO])) break; if (_sp > XB_SPIN_CAP) { atomicAdd(&(bar)[XB_TMO], 1u); break; } } } } while (0)
struct XcdBarrier { unsigned* bar; unsigned x; volatile LAS unsigned* st; };
__device__ __forceinline__ XcdBarrier xcd_barrier_post(unsigned* bar, volatile LAS unsigned* st) {
    XcdBarrier b; b.bar = bar; b.x = xb_xcc_id(); b.st = st;
    if (threadIdx.x == 0) (void)xb_add(&bar[XB_XCNT(b.x)], 1u);
    return b;
}
__device__ __forceinline__ void xcd_barrier_complete(unsigned* bar, unsigned x, unsigned& nloc, unsigned& nx) {
    const unsigned G = gridDim.x * gridDim.y * gridDim.z;
    unsigned sum, cnt, mine, sp = 0u;
    for (;;) {
        sum = 0u; cnt = 0u; mine = 0u;
#pragma unroll
        for (unsigned j = 0; j < 16; ++j) { const unsigned c = xb_ld(&bar[XB_XCNT(j)]); sum += c; cnt += (c > 0u) ? 1u : 0u; mine = (j == x) ? c : mine; }
        if (sum == G) break;
        __builtin_amdgcn_s_sleep(1);
        if ((++sp & 255u) == 0u) { if (xb_ld(&bar[XB_TMO])) break; if (sp > XB_SPIN_CAP) { atomicAdd(&bar[XB_TMO], 1u); break; } }
    }
    nloc = mine > 0u ? mine : 1u; nx = cnt > 0u ? cnt : 1u;
}
__device__ __forceinline__ void xcd_barrier(const XcdBarrier& b) {
    asm volatile("s_waitcnt vmcnt(0)" ::: "memory");
    __syncthreads();
    if (threadIdx.x == 0) {
        unsigned* bar = b.bar;
        __builtin_amdgcn_s_waitcnt(0);
        unsigned nloc = b.st[0], nx = b.st[1];
        if (nloc == 0u) { xcd_barrier_complete(bar, b.x, nloc, nx); b.st[0] = nloc; b.st[1] = nx; }
        const unsigned old = xb_add(&bar[XB_XSUB(b.x)], 1u);
        const unsigned gen = old / nloc;
        if (old + 1u == (gen + 1u) * nloc) {
            __builtin_amdgcn_fence(__ATOMIC_RELEASE, "agent");
            asm volatile("s_waitcnt vmcnt(0)" ::: "memory");
            const unsigned og = xb_add(&bar[XB_TOP], 1u);
            const unsigned tg = og / nx;
            if (og + 1u == (tg + 1u) * nx) xb_add(&bar[XB_TOPGEN], 1u);
            else XB_SPIN(xb_ld(&bar[XB_TOPGEN]) == tg, bar);
            __builtin_amdgcn_fence(__ATOMIC_ACQUIRE, "agent");
            xb_add(&bar[XB_XGEN(b.x)], 1u);
            asm volatile("s_waitcnt vmcnt(0)" ::: "memory");
        } else {
            XB_SPIN(xb_ld(&bar[XB_XGEN(b.x)]) == gen, bar);
            __builtin_amdgcn_fence(__ATOMIC_ACQUIRE, "agent");
            asm volatile("s_waitcnt vmcnt(0)" ::: "memory");
        }
    }
    __syncthreads();
}

constexpr int RING_BYTES = 131072, LDSCTL_OFF = RING_BYTES, MISC_OFF = LDSCTL_OFF + 320, LDS_BYTES = 147456;
constexpr int CW_BAR = 4096;
constexpr size_t CTL_ZERO_BYTES = 1 * MiB;

__global__ void __launch_bounds__(NT, 2) fwd_kernel(P p) {
    extern __shared__ __attribute__((aligned(16))) unsigned char lds_raw[];
    LAS unsigned char* lds = (LAS unsigned char*)lds_raw;
    unsigned char* ws = p.ws;
    for (int u = threadIdx.x; u < (LDS_BYTES - LDSCTL_OFF) / 4; u += NT) ((LAS unsigned*)(lds + LDSCTL_OFF))[u] = 0u;
    __syncthreads();
    const XcdBarrier bar = xcd_barrier_post((unsigned*)ws + CW_BAR, (volatile LAS unsigned*)(lds + MISC_OFF) + 8);
#define GRID_BAR() xcd_barrier(bar)
#define GEMM_RUN(g, E) do { pg8::StaticOrder S_; S_.init((g).M, (g).N, (int)gridDim.x, (int)blockIdx.x); pg8::gemm_phase<decltype(E), pg8::StaticOrder, true, true>(lds, (g), S_, (E)); } while (0)
    bf16* U = (bf16*)(ws + WS_U);
    const int vcu = (gridDim.x % 8 == 0) ? ((int)blockIdx.x % 8) * ((int)gridDim.x / 8) + (int)blockIdx.x / 8 : (int)blockIdx.x;
    ph_prologue(p, lds); ph_norm_in(p.x, U);
    GRID_BAR();
    { Gemm g{U, (const bf16*)(ws + WS_W1GU), M, NGU, DM}; EpiSwiglu E{(bf16*)(ws + WS_R1)}; GEMM_RUN(g, E); }
    GRID_BAR();
    { Gemm g{(const bf16*)(ws + WS_R1), (const bf16*)(ws + WS_W1D), M, DM, DFF}; EpiStoreF32 E{(float*)(ws + WS_R2), DM}; GEMM_RUN(g, E); }
    GRID_BAR();
    ph_norm_res((const float*)(ws + WS_R2), p.x, p.g1post, 0.5f, p.out, U);
    GRID_BAR();
    { Gemm g{U, (const bf16*)(ws + WS_WIN), M, PDIN, DM}; EpiStoreBf16 E{(bf16*)(ws + WS_R1), PDIN}; GEMM_RUN(g, E); }
    { Gemm g{(const bf16*)(ws + WS_WIN) + (size_t)PDIN * DM, U, 512, M, DM}; EpiStoreBf16 E{(bf16*)(ws + WS_VT), M}; GEMM_RUN(g, E); }
    GRID_BAR();
    ph_attn((const bf16*)(ws + WS_R1), (const bf16*)(ws + WS_VT), p.rpb, (bf16*)(ws + WS_ATT), vcu, (int)gridDim.x); ph_pool_v0((const bf16*)(ws + WS_R1), (bf16*)(ws + WS_POOLED));
    GRID_BAR();
    { Gemm g{(const bf16*)(ws + WS_ATT), (const bf16*)(ws + WS_WBA), M, DM, DATT}; EpiGateMul E{(const bf16*)(ws + WS_R1) + PGA, PDIN, (bf16*)(ws + WS_R2)}; GEMM_RUN(g, E); }
    GRID_BAR();
    { Gemm g{(const bf16*)(ws + WS_POOLED), (const bf16*)(ws + WS_WCOMB), M, DM, DPOOL}; EpiGateAdd E{(const bf16*)(ws + WS_R1) + PGP, PDIN, (const bf16*)(ws + WS_R2), (bf16*)(ws + WS_MERGED)}; GEMM_RUN(g, E); }
    GRID_BAR();
    { Gemm g{(const bf16*)(ws + WS_MERGED), (const bf16*)(ws + WS_WOUT), M, DM, DM}; EpiStoreF32 E{(float*)(ws + WS_R1), DM}; GEMM_RUN(g, E); }
    GRID_BAR();
    ph_norm_res((const float*)(ws + WS_R1), p.out, p.gmpost, 1.0f, p.out, U);
    GRID_BAR();
    { Gemm g{U, (const bf16*)(ws + WS_W2GU), M, NGU, DM}; EpiSwiglu E{(bf16*)(ws + WS_R1)}; GEMM_RUN(g, E); }
    GRID_BAR();
    { Gemm g{(const bf16*)(ws + WS_R1), (const bf16*)(ws + WS_W2D), M, DM, DFF}; EpiStoreF32 E{(float*)(ws + WS_R2), DM}; GEMM_RUN(g, E); }
    GRID_BAR();
    ph_norm_res((const float*)(ws + WS_R2), p.out, p.g2post, 0.5f, p.out, U); ph_cvt_p(p.p, (bf16*)(ws + WS_R1));
    GRID_BAR();
    { Gemm g{(const bf16*)(ws + WS_R1), (const bf16*)(ws + WS_WPP), M, DM, PLE}; EpiStoreF32 E{(float*)(ws + WS_T2), DM}; GEMM_RUN(g, E); }
    GRID_BAR();
    { Gemm g{U, (const bf16*)(ws + WS_WPG), M, DM, DM}; EpiPle E{(const float*)(ws + WS_T2), (float*)(ws + WS_R2)}; GEMM_RUN(g, E); }
    GRID_BAR();
    ph_norm_res((const float*)(ws + WS_R2), p.out, p.gppost, 1.0f, p.out, nullptr);
}

extern "C" void kernel_launch(void* const* d_in, const int* in_sizes, int n_in, void* d_out, int out_size, void* d_ws, size_t ws_size, hipStream_t stream) {
    static int grid = 0;
    if (grid == 0) {
        if (n_in != 25 || out_size != M * DM || ws_size < 512 * MiB) { fprintf(stderr, "kernel_launch: unexpected shapes n_in %d out %d ws %zu\n", n_in, out_size, ws_size); grid = -1; return; }
        int dev = 0, cus = 0, per_cu = 0;
        if (hipGetDevice(&dev) != hipSuccess || hipDeviceGetAttribute(&cus, hipDeviceAttributeMultiprocessorCount, dev) != hipSuccess) { grid = -1; return; }
        if (hipFuncSetAttribute((const void*)fwd_kernel, hipFuncAttributeMaxDynamicSharedMemorySize, LDS_BYTES) != hipSuccess) { fprintf(stderr, "kernel_launch: hipFuncSetAttribute failed\n"); grid = -1; return; }
        if (hipOccupancyMaxActiveBlocksPerMultiprocessor(&per_cu, (const void*)fwd_kernel, NT, LDS_BYTES) != hipSuccess || per_cu < 1) { fprintf(stderr, "kernel_launch: occupancy query says %d\n", per_cu); per_cu = 1; }
        (void)hipGetLastError();
        grid = cus;
    }
    if (grid < 0) return;
    if (hipMemsetAsync(d_ws, 0, CTL_ZERO_BYTES, stream) != hipSuccess) return;
    P p{};
    const float** f = (const float**)&p;
    for (int i = 0; i < 25; ++i) f[i] = (const float*)d_in[i];
    p.out = (float*)d_out; p.ws = (unsigned char*)d_ws;
    hipLaunchKernelGGL(fwd_kernel, dim3(grid), dim3(NT), LDS_BYTES, stream, p);
}
```
